# Optimizing an MI355X kernel written in HIP

```python
import math
import jax, jax.numpy as jnp
from jax import lax
import numpy as np

D_MODEL = 1024
BATCH = 16
SEQ = 2048
DEPTH = 1

RET_HEADS = 4
RET_DK = 128
RET_DV = 256
RET_CHUNK = 128
RET_ROT_BASE = 10000.0
MOBA_HEADS = 8
MOBA_DH = 64
MOBA_BLOCK = 256
MOBA_TOPK = 3
MOBA_QCHUNK = 128
ROPE_THETA = 500000.0
ROPE_DIMS = MOBA_DH // 4
D_FF = 2816
LN_EPS = 1e-5
GN_EPS = 1e-5
DEEPNORM_ALPHA = (2.0 * DEPTH) ** 0.25
DEEPNORM_BETA = (8.0 * DEPTH) ** -0.25
W_IN_SPLITS = (
    RET_HEADS * RET_DK,
    RET_HEADS * RET_DK,
    RET_HEADS * RET_DV,
    RET_HEADS * RET_DV,
    MOBA_HEADS * MOBA_DH,
    MOBA_HEADS * MOBA_DH,
    MOBA_HEADS * MOBA_DH,
    2 * D_MODEL,
)
W_IN_COLS = sum(W_IN_SPLITS)

kernel_name = "hybrid_retention_moba_macaron_deepnorm"


def layer_norm(x, g, b):
    xf = x.astype(jnp.float32)
    mu = jnp.mean(xf, axis=-1, keepdims=True)
    var = jnp.mean(jnp.square(xf - mu), axis=-1, keepdims=True)
    y = (xf - mu) * lax.rsqrt(var + LN_EPS) * g.astype(jnp.float32) + b.astype(jnp.float32)
    return y.astype(x.dtype)


def swiglu(x, w_gu, w_down):
    gate, up = jnp.split(x @ w_gu, 2, axis=-1)
    return (jax.nn.silu(gate) * up) @ w_down


def rotate(x, pos, inv_freq):
    ang = pos[:, None].astype(jnp.float32) * inv_freq[None, :]
    cos = jnp.cos(ang)[None, :, None, :]
    sin = jnp.sin(ang)[None, :, None, :]
    x1, x2 = jnp.split(x, 2, axis=-1)
    return jnp.concatenate([x1 * cos - x2 * sin, x1 * sin + x2 * cos], axis=-1)


def retention(q, k, v):
    B, S, H, DK = q.shape
    DV = v.shape[-1]
    C = RET_CHUNK
    n = S // C
    pos = jnp.arange(S)
    inv = 1.0 / (RET_ROT_BASE ** jnp.linspace(0.0, 1.0, DK // 2, dtype=jnp.float32))
    q = rotate(q, pos, inv)
    k = rotate(k, pos, inv) * (DK ** -0.5)
    log_g = jnp.log(1.0 - 2.0 ** (-5.0 - jnp.arange(H, dtype=jnp.float32)))

    qc = q.reshape(B, n, C, H, DK).transpose(0, 3, 1, 2, 4)
    kc = k.reshape(B, n, C, H, DK).transpose(0, 3, 1, 2, 4)
    vc = v.reshape(B, n, C, H, DV).transpose(0, 3, 1, 2, 4)

    idx = jnp.arange(C, dtype=jnp.float32)
    diff = idx[:, None] - idx[None, :]
    d_intra = jnp.where(diff >= 0, jnp.exp(log_g[:, None, None] * jnp.maximum(diff, 0.0)), 0.0)
    scores = jnp.einsum('bhncd,bhnkd->bhnck', qc, kc) * d_intra[:, None]
    intra = jnp.einsum('bhnck,bhnke->bhnce', scores, vc)

    k_dec = kc * jnp.exp(log_g[:, None] * (C - 1.0 - idx)[None, :])[:, None, :, None]
    kv = jnp.einsum('bhnkd,bhnke->nbhde', k_dec, vc)
    chunk_decay = jnp.exp(log_g * C)[None, :, None, None]

    def step(state, kv_n):
        return chunk_decay * state + kv_n, state

    _, prev = lax.scan(step, jnp.zeros((B, H, DK, DV), jnp.float32), kv)
    q_dec = qc * jnp.exp(log_g[:, None] * (idx + 1.0)[None, :])[:, None, :, None]
    cross = jnp.einsum('bhncd,nbhde->bhnce', q_dec, prev)

    out = (intra + cross).transpose(0, 2, 3, 1, 4).reshape(B, S, H, DV)
    mu = jnp.mean(out, axis=-1, keepdims=True)
    var = jnp.mean(jnp.square(out - mu), axis=-1, keepdims=True)
    out = (out - mu) * lax.rsqrt(var + GN_EPS)
    return out.reshape(B, S, H * DV)


def moba_attention(q, k, v):
    B, S, H, D = q.shape
    BLK = MOBA_BLOCK
    QC = MOBA_QCHUNK
    pos = jnp.arange(S)
    inv = 1.0 / (ROPE_THETA ** (jnp.arange(0, ROPE_DIMS, 2, dtype=jnp.float32) / ROPE_DIMS))
    q = jnp.concatenate([rotate(q[..., :ROPE_DIMS], pos, inv), q[..., ROPE_DIMS:]], axis=-1)
    k = jnp.concatenate([rotate(k[..., :ROPE_DIMS], pos, inv), k[..., ROPE_DIMS:]], axis=-1)

    nblk = -(-S // BLK)
    s_pad = nblk * BLK
    padw = ((0, 0), (0, s_pad - S), (0, 0), (0, 0))
    kb = jnp.pad(k, padw).reshape(B, nblk, BLK, H, D).transpose(0, 3, 1, 2, 4)
    vb = jnp.pad(v, padw).reshape(B, nblk, BLK, H, D).transpose(0, 3, 1, 2, 4)
    k_mean = jnp.mean(kb, axis=3)

    qh = q.transpose(0, 2, 1, 3)
    gate = jnp.einsum('bhsd,bhnd->bhsn', qh, k_mean)
    cur = pos // BLK
    past = jnp.arange(nblk)[None, :] < cur[:, None]
    gate = jnp.where(past[None, None], gate, -jnp.inf)
    n_sel = min(MOBA_TOPK, nblk)
    _, top_idx = lax.top_k(gate, n_sel)

    nqc = S // QC
    q_chunks = qh.reshape(B, H, nqc, QC, D).transpose(0, 2, 1, 3, 4).reshape(B * nqc, H, QC, D)
    i_chunks = top_idx.reshape(B, H, nqc, QC, n_sel).transpose(0, 2, 1, 3, 4).reshape(B * nqc, H, QC, n_sel)
    scale = D ** -0.5

    def attend(args):
        i, q_c, idx_c = args
        b = i // nqc
        c = i % nqc
        kb_b = lax.dynamic_index_in_dim(kb, b, 0, keepdims=False)
        vb_b = lax.dynamic_index_in_dim(vb, b, 0, keepdims=False)
        gk = jax.vmap(lambda kh, ih: kh[ih])(kb_b, idx_c)
        gv = jax.vmap(lambda vh, ih: vh[ih])(vb_b, idx_c)
        qpos = c * QC + jnp.arange(QC)
        s_sel = jnp.einsum('hqd,hqjpd->hqjp', q_c, gk) * scale
        sel_ok = jnp.arange(n_sel)[None, :] < (qpos // BLK)[:, None]
        s_sel = jnp.where(sel_ok[None, :, :, None], s_sel, -jnp.inf)
        own = (c * QC) // BLK
        ko = lax.dynamic_index_in_dim(kb_b, own, 1, keepdims=False)
        vo = lax.dynamic_index_in_dim(vb_b, own, 1, keepdims=False)
        s_own = jnp.einsum('hqd,hpd->hqp', q_c, ko) * scale
        kpos = own * BLK + jnp.arange(BLK)
        s_own = jnp.where((kpos[None, :] <= qpos[:, None])[None], s_own, -jnp.inf)
        logits = jnp.concatenate([s_sel.reshape(H, QC, n_sel * BLK), s_own], axis=-1)
        p = jax.nn.softmax(logits, axis=-1)
        p_sel = p[..., :n_sel * BLK].reshape(H, QC, n_sel, BLK)
        p_own = p[..., n_sel * BLK:]
        return jnp.einsum('hqjp,hqjpd->hqd', p_sel, gv) + jnp.einsum('hqp,hpd->hqd', p_own, vo)

    out = lax.map(attend, (jnp.arange(B * nqc), q_chunks, i_chunks))
    return out.reshape(B, nqc, H, QC, D).transpose(0, 1, 3, 2, 4).reshape(B, S, H * D)


def hybrid_mixer(h, w_in, ret_proj, moba_proj, w_out):
    B, S, _ = h.shape
    f32 = jnp.float32
    offs = np.cumsum(W_IN_SPLITS)[:-1].tolist()
    rq, rk, rv, rg, mq, mk, mv, gates = jnp.split(h @ w_in, offs, axis=-1)
    y_ret = retention(rq.reshape(B, S, RET_HEADS, RET_DK).astype(f32),
                      rk.reshape(B, S, RET_HEADS, RET_DK).astype(f32),
                      rv.reshape(B, S, RET_HEADS, RET_DV).astype(f32))
    y_ret = y_ret * jax.nn.silu(rg.astype(f32))
    y_a = y_ret.astype(h.dtype) @ ret_proj
    y_moba = moba_attention(mq.reshape(B, S, MOBA_HEADS, MOBA_DH).astype(f32),
                            mk.reshape(B, S, MOBA_HEADS, MOBA_DH).astype(f32),
                            mv.reshape(B, S, MOBA_HEADS, MOBA_DH).astype(f32))
    y_b = y_moba.astype(h.dtype) @ moba_proj
    g_a, g_b = jnp.split(jax.nn.sigmoid(gates), 2, axis=-1)
    return (g_a * y_a + g_b * y_b) @ w_out


def setup_inputs(seed: int = 0) -> dict:
    key = jax.random.key(seed)
    ks = jax.random.split(key, 16)
    f32 = jnp.float32
    L = DEPTH

    def nrm(k, shape, scale):
        return jax.random.normal(k, shape, f32) * scale

    return {
        "x": jax.random.normal(ks[0], (BATCH, SEQ, D_MODEL), f32),
        "ln1_g": 1.0 + nrm(ks[1], (L, D_MODEL), 0.02),
        "ln1_b": nrm(ks[2], (L, D_MODEL), 0.02),
        "ffn1_w_gu": nrm(ks[3], (L, D_MODEL, 2 * D_FF), D_MODEL ** -0.5),
        "ffn1_w_down": nrm(ks[4], (L, D_FF, D_MODEL), DEEPNORM_BETA * D_FF ** -0.5),
        "w_in": nrm(ks[5], (L, D_MODEL, W_IN_COLS), D_MODEL ** -0.5),
        "ret_proj": nrm(ks[6], (L, RET_HEADS * RET_DV, D_MODEL), (RET_HEADS * RET_DV) ** -0.5),
        "moba_proj": nrm(ks[7], (L, MOBA_HEADS * MOBA_DH, D_MODEL), (MOBA_HEADS * MOBA_DH) ** -0.5),
        "w_out": nrm(ks[8], (L, D_MODEL, D_MODEL), DEEPNORM_BETA * D_MODEL ** -0.5),
        "lnm_g": 1.0 + nrm(ks[9], (L, D_MODEL), 0.02),
        "lnm_b": nrm(ks[10], (L, D_MODEL), 0.02),
        "ffn2_w_gu": nrm(ks[11], (L, D_MODEL, 2 * D_FF), D_MODEL ** -0.5),
        "ffn2_w_down": nrm(ks[12], (L, D_FF, D_MODEL), DEEPNORM_BETA * D_FF ** -0.5),
        "ln2_g": 1.0 + nrm(ks[13], (L, D_MODEL), 0.02),
        "ln2_b": nrm(ks[14], (L, D_MODEL), 0.02),
    }


def reference(x, ln1_g, ln1_b, ffn1_w_gu, ffn1_w_down, w_in, ret_proj, moba_proj, w_out,
              lnm_g, lnm_b, ffn2_w_gu, ffn2_w_down, ln2_g, ln2_b):
    for l in range(DEPTH):
        x = layer_norm(DEEPNORM_ALPHA * x + 0.5 * swiglu(x, ffn1_w_gu[l], ffn1_w_down[l]), ln1_g[l], ln1_b[l])
        x = layer_norm(DEEPNORM_ALPHA * x + hybrid_mixer(x, w_in[l], ret_proj[l], moba_proj[l], w_out[l]),
                       lnm_g[l], lnm_b[l])
        x = layer_norm(DEEPNORM_ALPHA * x + 0.5 * swiglu(x, ffn2_w_gu[l], ffn2_w_down[l]), ln2_g[l], ln2_b[l])
    return x
```

```cpp
#include <hip/hip_runtime.h>
#include <hip/hip_cooperative_groups.h>
#include <cstdio>
#include <cstdint>
namespace pg8 {
#define PG8_LAS __attribute__((address_space(3)))
typedef unsigned short bf16_t;
typedef short bf16x8 __attribute__((ext_vector_type(8)));
typedef float f32x4 __attribute__((ext_vector_type(4)));
typedef unsigned u32x4 __attribute__((ext_vector_type(4)));
constexpr int BM = 256, BK = 64, HALF = 128, HTB = HALF * BK * 2  , STAGE_BYTES = 8 * HTB, NXCD = 8, WGM = 8;

__host__ __device__ __forceinline__ int lds_byte(int r, int c) { const int st = (r >> 4) * 2 + (c >> 5), rr = r & 15, cc = c & 31, ob = rr * 64 + cc * 2; return st * 1024 + (ob ^ (((ob >> 9) & 1) << 5)); }
__host__ __device__ __forceinline__ void stage_rc(int b, int& R, int& C) { const int st = b / 1024, sb = b % 1024, swz = sb ^ (((sb >> 9) & 1) << 5); R = (st >> 1) * 16 + swz / 64; C = (st & 1) * 32 + (swz % 64) / 2; }
__host__ __device__ __forceinline__ int perm32(int rho) { const int n = rho >> 4, i = rho & 15; return 8 * (i >> 2) + 4 * n + (i & 3); }

struct Unit { int pm, pn; };
struct Gemm { const bf16_t* A; const bf16_t* Bt; int M, N, K; };

struct StaticOrder {
    int nM, nN, nwg, G, c;
    __host__ __device__ void init(int M, int N, int G_, int c_) { nM = M / BM; nN = N / BM; nwg = nM * nN; G = G_; c = c_; }
    __host__ __device__ bool next(int i, Unit& u) const {
        const long L = (long)i * G + c; if (L >= nwg) return false;
        int wgid = (int)L; { const int q = nwg / NXCD, r = nwg % NXCD, xcd = wgid % NXCD, off = wgid / NXCD; wgid = (xcd < r ? xcd * (q + 1) : r * (q + 1) + (xcd - r) * q) + off; }
        const int nig = WGM * nN, gid = wgid / nig, fm = gid * WGM, gsz = (nM - fm) < WGM ? (nM - fm) : WGM;
        u.pm = fm + ((wgid % nig) % gsz); u.pn = (wgid % nig) / gsz; return true;
    }
    __device__ __forceinline__ void a_ready(const Unit&) const {}
    __device__ __forceinline__ void done(const Unit&) const {}
};

__device__ __forceinline__ unsigned cvt_pk_bf16(float lo, float hi) { unsigned r; asm volatile("v_cvt_pk_bf16_f32 %0, %1, %2" : "=v"(r) : "v"(lo), "v"(hi)); return r; }
typedef float f32x2 __attribute__((ext_vector_type(2)));
__device__ __forceinline__ f32x2 gelu_pk(f32x2 v) {
    const f32x2 av = __builtin_elementwise_abs(v), d = av * 0.2316418882f + 1.0f;
    f32x2 t; t.x = __builtin_amdgcn_rcpf(d.x); t.y = __builtin_amdgcn_rcpf(d.y);
    f32x2 q = t * 0.5307027145f + (-0.7265760135f); q = q * t + 0.7107068705f; q = q * t + (-0.142248368f); q = q * t + 0.127414796f; q = q * t;
    const f32x2 s = (v * v) * (-0.72134752044f);
    f32x2 e; e.x = __builtin_amdgcn_exp2f(s.x); e.y = __builtin_amdgcn_exp2f(s.y);
    const f32x2 m = v * (q * e), r = v - m;
    f32x2 o; o.x = v.x < 0.f ? m.x : r.x; o.y = v.y < 0.f ? m.y : r.y; return o;
}

template <int ACT  > struct EpiBf16 {
    static constexpr bool PERM = true, AFTER_DRAIN = false; static_assert(ACT == 0 || ACT == 1, "EpiBf16: ACT is 0 (none) or 1 (gelu_pk)");
    bf16_t* O; int ldc; const float* bias; int split_cols; size_t split_stride; float scale0;
    __device__ __forceinline__ void operator()(const f32x4 (&acc)[2][2][4][2], const Unit& u, int wr, int wc, int fr, int fq) const {
        const int row0 = u.pm * BM + wr * 64 + fr; int colt = u.pn * BM; bf16_t* base = O;
        float sc = 1.f; if (split_cols) { const int t = colt / split_cols; base += (size_t)t * split_stride; colt -= t * split_cols; if (t == 0) sc = scale0; }
        const int col0 = colt + wc * 32 + 8 * fq, bcol0 = u.pn * BM + wc * 32 + 8 * fq;
        f32x4 bv[2][2];
#pragma unroll
        for (int bj = 0; bj < 2; ++bj)
#pragma unroll
            for (int n = 0; n < 2; ++n) bv[bj][n] = bias ? *(const f32x4*)(bias + bcol0 + bj * HALF + 4 * n) : (f32x4){0.f, 0.f, 0.f, 0.f};
#pragma unroll
        for (int ai = 0; ai < 2; ++ai)
#pragma unroll
            for (int m = 0; m < 4; ++m) { bf16_t* rowp = base + (size_t)(row0 + ai * HALF + m * 16) * ldc + col0;
#pragma unroll
                for (int bj = 0; bj < 2; ++bj) { f32x4 v0 = acc[ai][bj][m][0] + bv[bj][0], v1 = acc[ai][bj][m][1] + bv[bj][1];
                    if (ACT == 1) { f32x2 a = gelu_pk((f32x2){v0[0], v0[1]}), b = gelu_pk((f32x2){v0[2], v0[3]}), c = gelu_pk((f32x2){v1[0], v1[1]}), d = gelu_pk((f32x2){v1[2], v1[3]});
                        v0 = (f32x4){a.x, a.y, b.x, b.y}; v1 = (f32x4){c.x, c.y, d.x, d.y}; }
                    v0 = v0 * sc; v1 = v1 * sc; u32x4 w; w.x = cvt_pk_bf16(v0[0], v0[1]); w.y = cvt_pk_bf16(v0[2], v0[3]); w.z = cvt_pk_bf16(v1[0], v1[1]); w.w = cvt_pk_bf16(v1[2], v1[3]);
                    *(u32x4*)(rowp + bj * HALF) = w; } }
    }
};

struct PanelStats {
    unsigned* xbuf;
    unsigned* cnt;
    unsigned* tmo;
    int ntn; float eps;
    unsigned code;
    __device__ __forceinline__ bool run(const f32x4 (&v)[2][2][4][2], const Unit& u, int wr, int wc, int fr, int fq, PG8_LAS unsigned char* lds, int wid, int lane) const {
        typedef float f32x2v __attribute__((ext_vector_type(2)));
        PG8_LAS f32x2v* P = (PG8_LAS f32x2v*)lds;
        PG8_LAS f32x2v* S = (PG8_LAS f32x2v*)(lds + 8192);
        PG8_LAS unsigned* flag = (PG8_LAS unsigned*)(lds + 8192 + 2048);
#pragma unroll
        for (int ai = 0; ai < 2; ++ai)
#pragma unroll
            for (int m = 0; m < 4; ++m) {
                float s = 0.f;
#pragma unroll
                for (int bj = 0; bj < 2; ++bj)
#pragma unroll
                    for (int n = 0; n < 2; ++n) { const f32x4 x = v[ai][bj][m][n]; s += (x[0] + x[1]) + (x[2] + x[3]); }
                s += __shfl_xor(s, 16); s += __shfl_xor(s, 32);
                const float mw = s * (1.0f / 64.0f); float q = 0.f;
#pragma unroll
                for (int bj = 0; bj < 2; ++bj)
#pragma unroll
                    for (int n = 0; n < 2; ++n) { const f32x4 d = v[ai][bj][m][n] - mw; q += (d[0] * d[0] + d[1] * d[1]) + (d[2] * d[2] + d[3] * d[3]); }
                q += __shfl_xor(q, 16); q += __shfl_xor(q, 32);
                if (fq == 0) P[(ai * HALF + wr * 64 + m * 16 + fr) * 4 + wc] = (f32x2v){mw, q};
            }
        asm volatile("s_waitcnt lgkmcnt(0)" ::: "memory"); __builtin_amdgcn_s_barrier(); asm volatile("" ::: "memory");
#if defined(BROKEN_EXCHANGE_NO_WAIT)
#warning BROKEN CONTROL BUILD: the row-statistics exchange does not wait; results are wrong by design
        if (blockIdx.x >= 64) { const long long t0_ = clock64(); while (clock64() - t0_ < 60000) __builtin_amdgcn_s_sleep(8); }
#endif
        const int row = wid * 32 + (lane & 31);
        if (lane < 32) {
            const f32x2v a = P[row * 4 + 0], b = P[row * 4 + 1], c = P[row * 4 + 2], d = P[row * 4 + 3];
            const float mt = (a.x + b.x + c.x + d.x) * 0.25f;
            const float da = a.x - mt, db = b.x - mt, dc = c.x - mt, dd = d.x - mt;
            const float m2 = (a.y + b.y) + (c.y + d.y) + 64.0f * ((da * da + db * db) + (dc * dc + dd * dd));
            unsigned long long* slot = (unsigned long long*)xbuf + ((size_t)(u.pm * BM + row) * 4 + u.pn);
            __hip_atomic_store(slot, ((unsigned long long)__float_as_uint(m2) << 32) | __float_as_uint(mt), __ATOMIC_RELAXED, __HIP_MEMORY_SCOPE_AGENT);
        }
        asm volatile("s_waitcnt vmcnt(0)" ::: "memory");
        if (lane == 0) __hip_atomic_fetch_add(cnt + 64 * u.pm, 1u, __ATOMIC_RELAXED, __HIP_MEMORY_SCOPE_AGENT);
        if (wid == 0) {
            bool dead = false; const unsigned long long t0 = __builtin_amdgcn_s_memrealtime(); const unsigned want = 8u * (unsigned)ntn;
            for (;;) {
#if defined(BROKEN_EXCHANGE_NO_WAIT)
                break;
#endif
                if ((unsigned)__builtin_amdgcn_readfirstlane(__hip_atomic_load(cnt + 64 * u.pm, __ATOMIC_RELAXED, __HIP_MEMORY_SCOPE_AGENT)) >= want) break;
                if (__builtin_amdgcn_s_memrealtime() - t0 > 2000000ull) {
                    if (lane == 0) { unsigned expect = 0u; __hip_atomic_compare_exchange_strong(tmo + 1, &expect, code | (unsigned)(u.pm & 0xff), __ATOMIC_RELAXED, __ATOMIC_RELAXED, __HIP_MEMORY_SCOPE_AGENT);
                                     __hip_atomic_store(tmo, 1u, __ATOMIC_RELAXED, __HIP_MEMORY_SCOPE_AGENT); }
                    dead = true; break; }
                __builtin_amdgcn_s_sleep(2);
            }
            __builtin_amdgcn_fence(__ATOMIC_ACQUIRE, "agent");
            if (lane == 0) flag[0] = dead ? 1u : 0u;
        }
        asm volatile("s_waitcnt vmcnt(0) lgkmcnt(0)" ::: "memory"); __builtin_amdgcn_s_barrier(); asm volatile("" ::: "memory");
        const bool bad = flag[0] != 0u;
        if (lane < 32) {
            const unsigned long long* slot = (const unsigned long long*)xbuf + (size_t)(u.pm * BM + row) * 4; float mt[4], m2[4]; float ms = 0.f;
#pragma unroll
            for (int t = 0; t < 4; ++t) { if (t < ntn) { const unsigned long long w = __hip_atomic_load(slot + t, __ATOMIC_RELAXED, __HIP_MEMORY_SCOPE_AGENT); mt[t] = __uint_as_float((unsigned)w); m2[t] = __uint_as_float((unsigned)(w >> 32)); } else { mt[t] = 0.f; m2[t] = 0.f; } ms += mt[t]; }
            const float mean = ms / (float)ntn; float q = 0.f;
#pragma unroll
            for (int t = 0; t < 4; ++t) if (t < ntn) { const float dm = mt[t] - mean; q += m2[t] + 256.0f * dm * dm; }
            S[row] = (f32x2v){mean, 1.0f / sqrtf(q / (256.0f * (float)ntn) + eps)};
        }
        asm volatile("s_waitcnt lgkmcnt(0)" ::: "memory"); __builtin_amdgcn_s_barrier(); asm volatile("" ::: "memory");
        return bad;
    }
};
struct EpiLnRes {
    static constexpr bool PERM = false, AFTER_DRAIN = true;
    const float* base; float* out; int ldc; const float* bias; PanelStats st; unsigned poison;
    __device__ __forceinline__ void fused(f32x4 (&acc)[2][2][4][2], const Unit& u, int wr, int wc, int fr, int fq, PG8_LAS unsigned char* lds, int wid, int lane) const {
        typedef float f32x2v __attribute__((ext_vector_type(2)));
        const PG8_LAS f32x2v* S = (const PG8_LAS f32x2v*)(lds + 8192);
        const int col0 = u.pn * BM + wc * 32 + 4 * fq;
#pragma unroll
        for (int bj = 0; bj < 2; ++bj)
#pragma unroll
            for (int n = 0; n < 2; ++n) { const f32x4 bv = bias ? *(const f32x4*)(bias + col0 + bj * HALF + n * 16) : (f32x4){0.f, 0.f, 0.f, 0.f};
#pragma unroll
                for (int ai = 0; ai < 2; ++ai)
#pragma unroll
                    for (int m = 0; m < 4; ++m) acc[ai][bj][m][n] += bv; }
        f32x4 pre[4][2][2];
#pragma unroll
        for (int m = 0; m < 4; ++m) { const size_t off = (size_t)(u.pm * BM + wr * 64 + m * 16 + fr) * ldc + col0;
#pragma unroll
            for (int bj = 0; bj < 2; ++bj)
#pragma unroll
                for (int n = 0; n < 2; ++n) pre[m][bj][n] = *(const f32x4*)(base + off + bj * HALF + n * 16); }
        const bool bad = st.run(acc, u, wr, wc, fr, fq, lds, wid, lane) || poison != 0u;
        const float qnan = __builtin_nanf("");
#pragma unroll
        for (int ai = 0; ai < 2; ++ai)
#pragma unroll
            for (int m = 0; m < 4; ++m) { const int r = ai * HALF + wr * 64 + m * 16 + fr; const f32x2v sr = S[r]; const size_t off = (size_t)(u.pm * BM + r) * ldc + col0;
#pragma unroll
                for (int bj = 0; bj < 2; ++bj)
#pragma unroll
                    for (int n = 0; n < 2; ++n) { const f32x4 bs = ai == 0 ? pre[m][bj][n] : *(const f32x4*)(base + off + bj * HALF + n * 16); f32x4 o = bs + (acc[ai][bj][m][n] - sr.x) * sr.y;
                        if (bad) o = (f32x4){qnan, qnan, qnan, qnan}; *(f32x4*)(out + off + bj * HALF + n * 16) = o; }
                if (m & 1) asm volatile("" ::: "memory"); }
    }
};
struct EpiLnResLn {
    static constexpr bool PERM = false, AFTER_DRAIN = true;
    const float* base; float* out; bf16_t* xn; int ldc; const float* bias; PanelStats st1, st2; unsigned poison;
    __device__ __forceinline__ void fused(f32x4 (&acc)[2][2][4][2], const Unit& u, int wr, int wc, int fr, int fq, PG8_LAS unsigned char* lds, int wid, int lane) const {
        typedef float f32x2v __attribute__((ext_vector_type(2))); typedef unsigned u32x2v __attribute__((ext_vector_type(2)));
        const PG8_LAS f32x2v* S = (const PG8_LAS f32x2v*)(lds + 8192);
        const int col0 = u.pn * BM + wc * 32 + 4 * fq;
#pragma unroll
        for (int bj = 0; bj < 2; ++bj)
#pragma unroll
            for (int n = 0; n < 2; ++n) { const f32x4 bv = bias ? *(const f32x4*)(bias + col0 + bj * HALF + n * 16) : (f32x4){0.f, 0.f, 0.f, 0.f};
#pragma unroll
                for (int ai = 0; ai < 2; ++ai)
#pragma unroll
                    for (int m = 0; m < 4; ++m) acc[ai][bj][m][n] += bv; }
        bool bad = st1.run(acc, u, wr, wc, fr, fq, lds, wid, lane) || poison != 0u;
        const float qnan = __builtin_nanf("");
#pragma unroll
        for (int ai = 0; ai < 2; ++ai)
#pragma unroll
            for (int m = 0; m < 4; ++m) { const int r = ai * HALF + wr * 64 + m * 16 + fr; const f32x2v sr = S[r]; const size_t off = (size_t)(u.pm * BM + r) * ldc + col0;
#pragma unroll
                for (int bj = 0; bj < 2; ++bj)
#pragma unroll
                    for (int n = 0; n < 2; ++n) { const f32x4 bs = *(const f32x4*)(base + off + bj * HALF + n * 16); acc[ai][bj][m][n] = bs + (acc[ai][bj][m][n] - sr.x) * sr.y; }
                asm volatile("" : "+v"(acc[ai][0][m][0]), "+v"(acc[ai][0][m][1]), "+v"(acc[ai][1][m][0]), "+v"(acc[ai][1][m][1]));
                if (m & 1) asm volatile("" ::: "memory"); }
        const bool bad1 = bad;
        bad = st2.run(acc, u, wr, wc, fr, fq, lds, wid, lane) || bad;
#pragma unroll
        for (int ai = 0; ai < 2; ++ai)
#pragma unroll
            for (int m = 0; m < 4; ++m) { const int r = ai * HALF + wr * 64 + m * 16 + fr; const f32x2v sr = S[r]; const size_t off = (size_t)(u.pm * BM + r) * ldc + col0;
#pragma unroll
                for (int bj = 0; bj < 2; ++bj)
#pragma unroll
                    for (int n = 0; n < 2; ++n) { const f32x4 x1 = acc[ai][bj][m][n]; *(f32x4*)(out + off + bj * HALF + n * 16) = bad1 ? (f32x4){qnan, qnan, qnan, qnan} : x1;
                        const f32x4 o = (x1 - sr.x) * sr.y; u32x2v w; w.x = cvt_pk_bf16(o[0], o[1]); w.y = cvt_pk_bf16(o[2], o[3]);
                        if (bad) { w.x = 0x7fc07fc0u; w.y = 0x7fc07fc0u; } *(u32x2v*)(xn + off + bj * HALF + n * 16) = w; }
                asm volatile("" ::: "memory"); }
    }
};

template <class Epi, class Sched, bool ALIGN_EPI = false, bool SP2 = false>
__device__ __forceinline__ void gemm_phase(PG8_LAS unsigned char* lds, const Gemm g, const Sched& S, const Epi& E) {
    const int tid = threadIdx.x, wid = __builtin_amdgcn_readfirstlane(tid >> 6), lane = tid & 63, wr = wid >> 2, wc = wid & 3, fr = lane & 15, fq = lane >> 4;
    const int K = g.K, nt = K / BK;
    unsigned voffA[2], voffB[2];
#pragma unroll
    for (int i = 0; i < 2; ++i) { int R, C; stage_rc(tid * 16 + i * 8192, R, C); const int Rb = Epi::PERM ? ((R & ~31) + perm32(R & 31)) : R;
        voffA[i] = (unsigned)(R * K + C) * 2u; voffB[i] = (unsigned)(Rb * K + C) * 2u; }
    const size_t kstep = (size_t)(BK * 2);
    const size_t hstep = (size_t)HALF * K * 2;
    const size_t tstep = 2 * hstep;
    const unsigned ldsw = (unsigned)wid * 1024u;
    const int aoff = lds_byte(wr * 64 + fr, fq * 8), boff = lds_byte(wc * 32 + fr, fq * 8);
#define PG8_SA(b, h) (((b) * 2 + (h)) * HTB)
#define PG8_SB(b, h) ((4 + (b) * 2 + (h)) * HTB)
#define PG8_STAGE(bufoff, gbase, voff) do { _Pragma("unroll") for (int _i = 0; _i < 2; ++_i) \
        __builtin_amdgcn_global_load_lds((const unsigned*)((const char*)(gbase) + (voff)[_i]), (PG8_LAS unsigned*)(lds + (bufoff) + ldsw + _i * 8192), 16, 0, 0); } while (0)
#define PG8_LDA(dst, b, h) do { _Pragma("unroll") for (int m = 0; m < 4; ++m) _Pragma("unroll") for (int k = 0; k < 2; ++k) dst[m][k] = *(const PG8_LAS bf16x8*)(lds + PG8_SA(b, h) + aoff + m * 2048 + k * 1024); } while (0)
#define PG8_LDB(dst, b, h) do { _Pragma("unroll") for (int n = 0; n < 2; ++n) _Pragma("unroll") for (int k = 0; k < 2; ++k) dst[n][k] = *(const PG8_LAS bf16x8*)(lds + PG8_SB(b, h) + boff + n * 2048 + k * 1024); } while (0)
#define PG8_MMA(ai, bj, At, Bt) do { __builtin_amdgcn_s_setprio(1); _Pragma("unroll") for (int m = 0; m < 4; ++m) _Pragma("unroll") for (int n = 0; n < 2; ++n) _Pragma("unroll") for (int k = 0; k < 2; ++k) \
        acc[ai][bj][m][n] = __builtin_amdgcn_mfma_f32_16x16x32_bf16(Bt[n][k], At[m][k], acc[ai][bj][m][n], 0, 0, 0); __builtin_amdgcn_s_setprio(0); } while (0)
#define PG8_WAIT_V(n) asm volatile("s_waitcnt vmcnt(" #n ")" ::: "memory")
#define PG8_WAIT_L(n) asm volatile("s_waitcnt lgkmcnt(" #n ")" ::: "memory")
#define PG8_BAR __builtin_amdgcn_s_barrier()
#define PG8_SCHED __builtin_amdgcn_sched_barrier(0)
    Unit cur, nxt; int ui = 0;
    if (!S.next(0, cur)) return;
    f32x4 acc[2][2][4][2];
#pragma unroll
    for (int a = 0; a < 2; ++a)
#pragma unroll
        for (int b = 0; b < 2; ++b)
#pragma unroll
            for (int m = 0; m < 4; ++m)
#pragma unroll
                for (int n = 0; n < 2; ++n) acc[a][b][m][n] = (f32x4){0.f, 0.f, 0.f, 0.f};
    bf16x8 At[4][2], B0[2][2], B1[2][2];
    const char* cA = (const char*)g.A + (size_t)cur.pm * tstep; const char* cB = (const char*)g.Bt + (size_t)cur.pn * tstep;
    S.a_ready(cur);
    if constexpr (SP2) {
        PG8_STAGE(PG8_SB(0, 0), cB, voffB); PG8_STAGE(PG8_SB(0, 1), cB + hstep, voffB); PG8_STAGE(PG8_SA(0, 0), cA, voffA); PG8_STAGE(PG8_SA(0, 1), cA + hstep, voffA);
        if (wr == 1) PG8_BAR;
        PG8_WAIT_V(2); PG8_BAR;
        PG8_STAGE(PG8_SB(1, 0), cB + kstep, voffB); PG8_STAGE(PG8_SA(1, 0), cA + kstep, voffA); PG8_STAGE(PG8_SB(1, 1), cB + hstep + kstep, voffB);
        PG8_WAIT_V(6); PG8_BAR;
    } else {
        PG8_STAGE(PG8_SB(0, 0), cB, voffB); PG8_STAGE(PG8_SA(0, 0), cA, voffA); PG8_STAGE(PG8_SB(0, 1), cB + hstep, voffB); PG8_STAGE(PG8_SA(0, 1), cA + hstep, voffA);
        if (wr == 1) PG8_BAR;
        PG8_WAIT_V(4); PG8_BAR;
        PG8_STAGE(PG8_SB(1, 0), cB + kstep, voffB); PG8_STAGE(PG8_SA(1, 0), cA + kstep, voffA); PG8_STAGE(PG8_SB(1, 1), cB + hstep + kstep, voffB);
        PG8_WAIT_V(6); PG8_BAR;
    }
    for (;;) {
        const bool has_next = S.next(ui + 1, nxt);
        const char* nA = has_next ? (const char*)g.A + (size_t)nxt.pm * tstep : cA; const char* nB = has_next ? (const char*)g.Bt + (size_t)nxt.pn * tstep : cB;
        for (int t = 0; t < nt; t += 2) {
            const bool last = (t == nt - 2);
            const char* a1 = cA + (size_t)(t + 1) * kstep;
            const char* a2 = last ? nA : cA + (size_t)(t + 2) * kstep; const char* b2 = last ? nB : cB + (size_t)(t + 2) * kstep;
            const char* a3 = a2 + kstep; const char* b3 = b2 + kstep;
            if (last && has_next) S.a_ready(nxt);
            if constexpr (SP2) {
            PG8_LDB(B0, 0, 0); PG8_LDB(B1, 0, 1); PG8_SCHED; PG8_LDA(At, 0, 0); PG8_STAGE(PG8_SA(1, 1), a1 + hstep, voffA);
            PG8_WAIT_V(8); PG8_WAIT_L(0); PG8_BAR; PG8_MMA(0, 0, At, B0); PG8_MMA(0, 1, At, B1); PG8_BAR; PG8_SCHED;
            PG8_LDA(At, 0, 1); PG8_STAGE(PG8_SB(0, 0), b2, voffB); PG8_STAGE(PG8_SB(0, 1), b2 + hstep, voffB); PG8_STAGE(PG8_SA(0, 0), a2, voffA);
            PG8_WAIT_V(8); PG8_WAIT_L(0); PG8_BAR; PG8_MMA(1, 0, At, B0); PG8_MMA(1, 1, At, B1); PG8_BAR; PG8_SCHED;
            PG8_LDB(B0, 1, 0); PG8_LDB(B1, 1, 1); PG8_SCHED; PG8_LDA(At, 1, 0); PG8_STAGE(PG8_SA(0, 1), a2 + hstep, voffA);
            PG8_WAIT_V(8); PG8_WAIT_L(0); PG8_BAR; PG8_MMA(0, 0, At, B0); PG8_MMA(0, 1, At, B1); PG8_BAR; PG8_SCHED;
            PG8_LDA(At, 1, 1); PG8_STAGE(PG8_SB(1, 0), b3, voffB); PG8_STAGE(PG8_SB(1, 1), b3 + hstep, voffB); PG8_STAGE(PG8_SA(1, 0), a3, voffA);
            PG8_WAIT_V(8); PG8_WAIT_L(0); PG8_BAR; PG8_MMA(1, 0, At, B0); PG8_MMA(1, 1, At, B1); PG8_BAR; PG8_SCHED;
            } else {
            PG8_LDB(B0, 0, 0); PG8_SCHED; PG8_LDA(At, 0, 0); PG8_STAGE(PG8_SA(1, 1), a1 + hstep, voffA);
            PG8_WAIT_L(8); PG8_BAR; PG8_WAIT_L(0); PG8_MMA(0, 0, At, B0); PG8_BAR; PG8_SCHED;
            PG8_LDB(B1, 0, 1); PG8_STAGE(PG8_SB(0, 0), b2, voffB);
            PG8_BAR; PG8_WAIT_L(0); PG8_MMA(0, 1, At, B1); PG8_BAR;
            PG8_LDA(At, 0, 1); PG8_STAGE(PG8_SA(0, 0), a2, voffA);
            PG8_BAR; PG8_WAIT_L(0); PG8_MMA(1, 0, At, B0); PG8_BAR; PG8_SCHED;
            PG8_STAGE(PG8_SB(0, 1), b2 + hstep, voffB);
            PG8_WAIT_V(6); PG8_BAR; PG8_MMA(1, 1, At, B1); PG8_BAR;
            PG8_LDB(B0, 1, 0); PG8_SCHED; PG8_LDA(At, 1, 0); PG8_STAGE(PG8_SA(0, 1), a2 + hstep, voffA);
            PG8_WAIT_L(8); PG8_BAR; PG8_WAIT_L(0); PG8_MMA(0, 0, At, B0); PG8_BAR; PG8_SCHED;
            PG8_LDB(B1, 1, 1); PG8_STAGE(PG8_SB(1, 0), b3, voffB);
            PG8_BAR; PG8_WAIT_L(0); PG8_MMA(0, 1, At, B1); PG8_BAR;
            PG8_LDA(At, 1, 1); PG8_STAGE(PG8_SA(1, 0), a3, voffA);
            PG8_BAR; PG8_WAIT_L(0); PG8_MMA(1, 0, At, B0); PG8_BAR; PG8_SCHED;
            PG8_STAGE(PG8_SB(1, 1), b3 + hstep, voffB);
            PG8_WAIT_V(6); PG8_BAR; PG8_MMA(1, 1, At, B1); PG8_BAR;
            }
        }
        if constexpr (ALIGN_EPI) { if (wr == 0) PG8_BAR; }
        if constexpr (!Epi::AFTER_DRAIN) { E(acc, cur, wr, wc, fr, fq); S.done(cur); }
        if (!has_next) break;
#pragma unroll
        for (int a = 0; a < 2; ++a)
#pragma unroll
            for (int b = 0; b < 2; ++b)
#pragma unroll
                for (int m = 0; m < 4; ++m)
#pragma unroll
                    for (int n = 0; n < 2; ++n) acc[a][b][m][n] = (f32x4){0.f, 0.f, 0.f, 0.f};
        cur = nxt; cA = nA; cB = nB; ++ui;
        if constexpr (ALIGN_EPI) { if (wr == 1) PG8_BAR; }
    }
    PG8_WAIT_V(0);
    if constexpr (!ALIGN_EPI) { if (wr == 0) PG8_BAR; }
    PG8_BAR;
    if constexpr (Epi::AFTER_DRAIN) { E.fused(acc, cur, wr, wc, fr, fq, lds, wid, lane); S.done(cur); }
#undef PG8_SA
#undef PG8_SB
#undef PG8_STAGE
#undef PG8_LDA
#undef PG8_LDB
#undef PG8_MMA
#undef PG8_WAIT_V
#undef PG8_WAIT_L
#undef PG8_BAR
#undef PG8_SCHED
}
}
#ifndef PG8_SP2
#define PG8_SP2 true
#endif
#ifndef PG8_ALIGN
#define PG8_ALIGN true
#endif
namespace pg8 {
typedef unsigned u32x2 __attribute__((ext_vector_type(2)));
__device__ __forceinline__ float bf2f(unsigned short h) { return __uint_as_float((unsigned)h << 16); }
__device__ __forceinline__ float bflo(unsigned w) { return __uint_as_float(w << 16); }
__device__ __forceinline__ float bfhi(unsigned w) { return __uint_as_float(w & 0xffff0000u); }
__device__ __forceinline__ float silu_f(float g) { return g * __builtin_amdgcn_rcpf(1.0f + __builtin_amdgcn_exp2f(-1.4426950408889634f * g)); }
__device__ __forceinline__ float sigm_f(float g) { return __builtin_amdgcn_rcpf(1.0f + __builtin_amdgcn_exp2f(-1.4426950408889634f * g)); }

struct EpiSwiGLU {
    static constexpr bool PERM = true, AFTER_DRAIN = false;
    bf16_t* O; int ldc;
    __device__ __forceinline__ void operator()(const f32x4 (&acc)[2][2][4][2], const Unit& u, int wr, int wc, int fr, int fq) const {
        const int row0 = u.pm * BM + wr * 64 + fr, col0 = u.pn * HALF + wc * 32 + 8 * fq;
#pragma unroll
        for (int ai = 0; ai < 2; ++ai)
#pragma unroll
            for (int m = 0; m < 4; ++m) { bf16_t* rowp = O + (size_t)(row0 + ai * HALF + m * 16) * ldc + col0;
                float h[8];
#pragma unroll
                for (int n = 0; n < 2; ++n)
#pragma unroll
                    for (int i = 0; i < 4; ++i) h[n * 4 + i] = silu_f(acc[ai][0][m][n][i]) * acc[ai][1][m][n][i];
                u32x4 w; w.x = cvt_pk_bf16(h[0], h[1]); w.y = cvt_pk_bf16(h[2], h[3]); w.z = cvt_pk_bf16(h[4], h[5]); w.w = cvt_pk_bf16(h[6], h[7]);
                *(u32x4*)rowp = w; }
    }
};
struct EpiResid {
    static constexpr bool PERM = false, AFTER_DRAIN = false;
    const float* base; float* out; int ldc; float alpha, s;
    __device__ __forceinline__ void operator()(const f32x4 (&acc)[2][2][4][2], const Unit& u, int wr, int wc, int fr, int fq) const {
        const int row0 = u.pm * BM + wr * 64 + fr, col0 = u.pn * BM + wc * 32 + 4 * fq;
#pragma unroll
        for (int ai = 0; ai < 2; ++ai)
#pragma unroll
            for (int m = 0; m < 4; ++m) { const size_t off = (size_t)(row0 + ai * HALF + m * 16) * ldc + col0;
#pragma unroll
                for (int bj = 0; bj < 2; ++bj)
#pragma unroll
                    for (int n = 0; n < 2; ++n) { const f32x4 b = *(const f32x4*)(base + off + bj * HALF + n * 16);
                        *(f32x4*)(out + off + bj * HALF + n * 16) = b * alpha + acc[ai][bj][m][n] * s; } }
    }
};
struct EpiProj {
    static constexpr bool PERM = true, AFTER_DRAIN = false;
    bf16_t *rq, *rk, *rv, *sg, *mq, *mk, *mv, *gt;
    __device__ __forceinline__ void operator()(const f32x4 (&acc)[2][2][4][2], const Unit& u, int wr, int wc, int fr, int fq) const {
        const int pn = u.pn; bf16_t* dst; int ldc, tb, act = 0;
        if (pn < 2) { dst = rq; ldc = 512; tb = pn; }
        else if (pn < 4) { dst = rk; ldc = 512; tb = pn - 2; }
        else if (pn < 8) { dst = rv; ldc = 1024; tb = pn - 4; }
        else if (pn < 12) { dst = sg; ldc = 1024; tb = pn - 8; act = 1; }
        else if (pn < 14) { dst = mq; ldc = 512; tb = pn - 12; }
        else if (pn < 16) { dst = mk; ldc = 512; tb = pn - 14; }
        else if (pn < 18) { dst = mv; ldc = 512; tb = pn - 16; }
        else { dst = gt; ldc = 2048; tb = pn - 18; act = 2; }
        const int row0 = u.pm * BM + wr * 64 + fr, col0 = tb * BM + wc * 32 + 8 * fq;
#pragma unroll
        for (int ai = 0; ai < 2; ++ai)
#pragma unroll
            for (int m = 0; m < 4; ++m) { bf16_t* rowp = dst + (size_t)(row0 + ai * HALF + m * 16) * ldc + col0;
#pragma unroll
                for (int bj = 0; bj < 2; ++bj) { f32x4 v0 = acc[ai][bj][m][0], v1 = acc[ai][bj][m][1];
                    if (act == 1) {
#pragma unroll
                        for (int i = 0; i < 4; ++i) { v0[i] = silu_f(v0[i]); v1[i] = silu_f(v1[i]); } }
                    else if (act == 2) {
#pragma unroll
                        for (int i = 0; i < 4; ++i) { v0[i] = sigm_f(v0[i]); v1[i] = sigm_f(v1[i]); } }
                    u32x4 w; w.x = cvt_pk_bf16(v0[0], v0[1]); w.y = cvt_pk_bf16(v0[2], v0[3]); w.z = cvt_pk_bf16(v1[0], v1[1]); w.w = cvt_pk_bf16(v1[2], v1[3]);
                    *(u32x4*)(rowp + bj * HALF) = w; } }
    }
};
struct EpiGateA {
    static constexpr bool PERM = false, AFTER_DRAIN = false;
    const bf16_t* gt; float* T;
    __device__ __forceinline__ void operator()(const f32x4 (&acc)[2][2][4][2], const Unit& u, int wr, int wc, int fr, int fq) const {
        const int row0 = u.pm * BM + wr * 64 + fr, col0 = u.pn * BM + wc * 32 + 4 * fq;
#pragma unroll
        for (int ai = 0; ai < 2; ++ai)
#pragma unroll
            for (int m = 0; m < 4; ++m) { const size_t r = (size_t)(row0 + ai * HALF + m * 16);
#pragma unroll
                for (int bj = 0; bj < 2; ++bj)
#pragma unroll
                    for (int n = 0; n < 2; ++n) { const int c = col0 + bj * HALF + n * 16; const u32x2 g = *(const u32x2*)(gt + r * 2048 + c);
                        f32x4 o; o[0] = bflo(g.x) * acc[ai][bj][m][n][0]; o[1] = bfhi(g.x) * acc[ai][bj][m][n][1]; o[2] = bflo(g.y) * acc[ai][bj][m][n][2]; o[3] = bfhi(g.y) * acc[ai][bj][m][n][3];
                        *(f32x4*)(T + r * 1024 + c) = o; } }
    }
};
struct EpiGateB {
    static constexpr bool PERM = false, AFTER_DRAIN = false;
    const bf16_t* gt; const float* T; bf16_t* Z;
    __device__ __forceinline__ void operator()(const f32x4 (&acc)[2][2][4][2], const Unit& u, int wr, int wc, int fr, int fq) const {
        const int row0 = u.pm * BM + wr * 64 + fr, col0 = u.pn * BM + wc * 32 + 4 * fq;
#pragma unroll
        for (int ai = 0; ai < 2; ++ai)
#pragma unroll
            for (int m = 0; m < 4; ++m) { const size_t r = (size_t)(row0 + ai * HALF + m * 16);
#pragma unroll
                for (int bj = 0; bj < 2; ++bj)
#pragma unroll
                    for (int n = 0; n < 2; ++n) { const int c = col0 + bj * HALF + n * 16; const u32x2 g = *(const u32x2*)(gt + r * 2048 + 1024 + c);
                        const f32x4 t = *(const f32x4*)(T + r * 1024 + c);
                        const float o0 = t[0] + bflo(g.x) * acc[ai][bj][m][n][0], o1 = t[1] + bfhi(g.x) * acc[ai][bj][m][n][1], o2 = t[2] + bflo(g.y) * acc[ai][bj][m][n][2], o3 = t[3] + bfhi(g.y) * acc[ai][bj][m][n][3];
                        u32x2 w; w.x = cvt_pk_bf16(o0, o1); w.y = cvt_pk_bf16(o2, o3);
                        *(u32x2*)(Z + r * 1024 + c) = w; } }
    }
};
}
namespace cg = cooperative_groups;
#ifndef MK_SINGLE
#define MK_SINGLE 1
#endif
constexpr int NWAVES = 8, NTHR = 512;
constexpr int BATCH = 16, SEQ = 2048, M = BATCH * SEQ, D = 1024, FF = 2816, NGU = 2 * FF, NIN = 6656;
constexpr int RH = 4, RDK = 128, RDV = 256, RC = 128, RNC = SEQ / RC;
constexpr int MH = 8, MDH = 64, MBLK = 256, MNB = SEQ / MBLK;
constexpr float ALPHA = 1.189207115002721f;
constexpr float LN_EPS = 1e-5f, GN_EPS = 1e-5f;
constexpr size_t MiB = 1u << 20;
constexpr size_t WS_CTL = 0, CTL_ZERO_BYTES = 1 * MiB;
constexpr size_t WS_KMEAN = 1 * MiB;
constexpr size_t WS_WIN = 2 * MiB, WS_WRP = 15 * MiB, WS_WMP = 17 * MiB, WS_WOUT = 18 * MiB;
constexpr size_t WS_XNB = 20 * MiB;
constexpr size_t WS_ST = WS_XNB;
constexpr size_t WS_U = 84 * MiB;
constexpr size_t WS_H = WS_U;
constexpr size_t WS_WGU1 = WS_U + 176 * MiB, WS_WD1 = WS_WGU1 + 11 * MiB;
constexpr size_t WS_RQ = WS_U, WS_RK = WS_U + 32 * MiB, WS_MK = WS_U + 64 * MiB, WS_MV = WS_U + 96 * MiB, WS_RV = WS_U + 128 * MiB,
                 WS_SG = WS_U + 192 * MiB, WS_MQ = WS_U + 256 * MiB, WS_GT = WS_U + 288 * MiB;
constexpr size_t WS_T = WS_U, WS_Z = WS_U + 128 * MiB;
constexpr size_t WS_WGU2 = WS_U + 288 * MiB, WS_WD2 = WS_WGU2 + 11 * MiB;
constexpr size_t WS_END = 500 * MiB;
constexpr int RING_BYTES = 131072, LDSCTL_OFF = 143360, LDS_BYTES = 147456;

#define GAS __attribute__((address_space(1)))
#define LAS __attribute__((address_space(3)))
typedef unsigned short bf16;
typedef unsigned v4u __attribute__((ext_vector_type(4)));
typedef unsigned v2u __attribute__((ext_vector_type(2)));
typedef float f32x4 __attribute__((ext_vector_type(4)));
__device__ __forceinline__ unsigned f2bf(float f) { unsigned u = __builtin_bit_cast(unsigned, f); return (u + 0x7fffu + ((u >> 16) & 1u)) >> 16; }
__device__ __forceinline__ unsigned pk2(float lo, float hi) { return f2bf(lo) | (f2bf(hi) << 16); }
__device__ __forceinline__ float bf2f(unsigned short h) { return __uint_as_float((unsigned)h << 16); }
__device__ __forceinline__ float bflo(unsigned w) { return __uint_as_float(w << 16); }
__device__ __forceinline__ float bfhi(unsigned w) { return __uint_as_float(w & 0xffff0000u); }
#define LDS_WAIT() asm volatile("s_waitcnt lgkmcnt(0)" ::: "memory")

struct Args { const float* in[15]; float* out; unsigned char* ws; int ph_lo, ph_hi; };
struct Frame {
    LAS unsigned char* lds;
    int tid, lane, wave, G, bid;
    const float* x; float* out; unsigned char* ws;
};

__device__ __forceinline__ float wave_sum(float v) {
#pragma unroll
    for (int o = 1; o < 64; o <<= 1) v += __shfl_xor(v, o);
    return v;
}
__device__ __forceinline__ void transpose_item(const float* W, int K, int N, bf16* WT, int k0, int n0, int drow0, LAS float* scr, int lane) {
#pragma unroll 8
    for (int i = 0; i < 32; ++i) { const int kk = 2 * i + (lane >> 5); scr[kk * 33 + (lane & 31)] = W[(size_t)(k0 + kk) * N + n0 + (lane & 31)]; }
    LDS_WAIT(); asm volatile("" ::: "memory");
    const int c = lane & 7;
#pragma unroll
    for (int j = 0; j < 4; ++j) { const int n = (lane >> 3) + 8 * j; const LAS float* s = scr + (8 * c) * 33 + n;
        v4u o; o.x = pk2(s[0 * 33], s[1 * 33]); o.y = pk2(s[2 * 33], s[3 * 33]); o.z = pk2(s[4 * 33], s[5 * 33]); o.w = pk2(s[6 * 33], s[7 * 33]);
        *(v4u*)(WT + (size_t)(drow0 + n) * K + k0 + 8 * c) = o; }
    LDS_WAIT(); asm volatile("" ::: "memory");
}
__device__ __forceinline__ void transpose_plain(Frame& F, const float* W, int K, int N, bf16* WT, int gw0, int NGW) {
    LAS float* scr = (LAS float*)(F.lds + F.wave * 16384);
    const int nblk = N / 32, nitems = (K / 64) * nblk;
    for (int it = gw0; it < nitems; it += NGW) { const int kb = it / nblk, nb = it % nblk; transpose_item(W, K, N, WT, 64 * kb, 32 * nb, 32 * nb, scr, F.lane); }
}
__device__ __forceinline__ void transpose_gu(Frame& F, const float* W, bf16* WT, int gw0, int NGW) {
    LAS float* scr = (LAS float*)(F.lds + F.wave * 16384);
    const int nblk = NGU / 32, nitems = (D / 64) * nblk;
    for (int it = gw0; it < nitems; it += NGW) { const int kb = it / nblk, nb = it % nblk; const int n0 = 32 * nb; const int up = n0 >= FF ? 1 : 0, j = n0 - up * FF;
        transpose_item(W, D, NGU, WT, 64 * kb, n0, 256 * (j >> 7) + 128 * up + (j & 127), scr, F.lane); }
}
__device__ __forceinline__ void cvt_rows(Frame& F, const float* X, bf16* XB, int gw0, int NGW) {
    for (int m = gw0; m < M; m += NGW) { const f32x4* xr = (const f32x4*)(X + (size_t)m * D) + F.lane; unsigned long long* o8 = (unsigned long long*)(XB + (size_t)m * D) + F.lane;
#pragma unroll
        for (int j = 0; j < 4; ++j) { const f32x4 v = xr[64 * j]; o8[64 * j] = (unsigned long long)pk2(v.x, v.y) | ((unsigned long long)pk2(v.z, v.w) << 32); } }
}
__device__ __forceinline__ void ln_rows(Frame& F, float* X, bf16* XB, const float* g, const float* b, int gw0, int NGW) {
    for (int m = gw0; m < M; m += NGW) {
        f32x4* xr = (f32x4*)(X + (size_t)m * D) + F.lane;
        f32x4 v[4]; float s = 0.f;
#pragma unroll
        for (int j = 0; j < 4; ++j) { v[j] = xr[64 * j]; s += (v[j].x + v[j].y) + (v[j].z + v[j].w); }
        const float mean = wave_sum(s) * (1.f / D); float s2 = 0.f;
#pragma unroll
        for (int j = 0; j < 4; ++j) { v[j] = v[j] - mean; s2 += (v[j].x * v[j].x + v[j].y * v[j].y) + (v[j].z * v[j].z + v[j].w * v[j].w); }
        const float rstd = 1.f / sqrtf(wave_sum(s2) * (1.f / D) + LN_EPS);
#pragma unroll
        for (int j = 0; j < 4; ++j) { const f32x4 gg = ((const f32x4*)g)[F.lane + 64 * j], bb = ((const f32x4*)b)[F.lane + 64 * j];
            const f32x4 o = v[j] * rstd * gg + bb; xr[64 * j] = o;
            if (XB) ((unsigned long long*)(XB + (size_t)m * D))[F.lane + 64 * j] = (unsigned long long)pk2(o.x, o.y) | ((unsigned long long)pk2(o.z, o.w) << 32); }
    }
}

__device__ __forceinline__ float ret_log2g(int h) { return log2f(1.0f - exp2f(-5.0f - (float)h)); }
__device__ __forceinline__ float ret_inv(int i) { return 1.0f / powf(10000.0f, (float)i / 63.0f); }
__device__ __forceinline__ float moba_inv(int i) { return 1.0f / powf(500000.0f, (float)i / 8.0f); }

__device__ __forceinline__ void ret_kv_item(Frame& F, int item) {
    const int n = item & 15, h = (item >> 4) & 3, b = item >> 6, tid = F.tid;
    const size_t row0 = (size_t)b * SEQ + n * RC;
    const bf16* RK = (const bf16*)(F.ws + WS_RK); const bf16* RV = (const bf16*)(F.ws + WS_RV); bf16* ST = (bf16*)(F.ws + WS_ST);
    LAS float* Kf = (LAS float*)F.lds; LAS bf16* Vb = (LAS bf16*)(F.lds + 65536);
    const float lg2 = ret_log2g(h);
    for (int idx = tid; idx < RC * 64; idx += NTHR) { const int k = idx >> 6, i = idx & 63;
        const bf16* kr = RK + (row0 + k) * 512 + h * RDK;
        const float x1 = bf2f(kr[i]), x2 = bf2f(kr[i + 64]);
        const float ang = (float)(n * RC + k) * ret_inv(i); const float c = cosf(ang), s = sinf(ang);
        const float f = 0.08838834764831845f * exp2f(lg2 * (float)(RC - 1 - k));
        Kf[k * RDK + i] = (x1 * c - x2 * s) * f; Kf[k * RDK + i + 64] = (x1 * s + x2 * c) * f; }
    for (int idx = tid; idx < RC * 32; idx += NTHR) { const int k = idx >> 5, ch = idx & 31;
        *(LAS v4u*)(Vb + k * RDV + ch * 8) = *(const v4u*)(RV + (row0 + k) * 1024 + h * RDV + ch * 8); }
    __syncthreads();
    const int d = tid & 127, eg = tid >> 7;
    float acc[64];
#pragma unroll
    for (int i = 0; i < 64; ++i) acc[i] = 0.f;
    for (int k = 0; k < RC; ++k) { const float kd = Kf[k * RDK + d];
#pragma unroll
        for (int c8 = 0; c8 < 8; ++c8) { const v4u w = *(const LAS v4u*)(Vb + k * RDV + eg * 64 + c8 * 8);
            acc[c8 * 8 + 0] += kd * bflo(w.x); acc[c8 * 8 + 1] += kd * bfhi(w.x); acc[c8 * 8 + 2] += kd * bflo(w.y); acc[c8 * 8 + 3] += kd * bfhi(w.y);
            acc[c8 * 8 + 4] += kd * bflo(w.z); acc[c8 * 8 + 5] += kd * bfhi(w.z); acc[c8 * 8 + 6] += kd * bflo(w.w); acc[c8 * 8 + 7] += kd * bfhi(w.w); } }
#pragma unroll
    for (int i = 0; i < 64; ++i) ST[((size_t)item * RDV + eg * 64 + i) * RDK + d] = (bf16)f2bf(acc[i]);
    __syncthreads();
}
__device__ __forceinline__ void moba_kprep_item(Frame& F, int item) {
    const int blk = item & 7, b = item >> 3, head = F.tid >> 6, dd = F.tid & 63;
    bf16* MK = (bf16*)(F.ws + WS_MK); float* KM = (float*)(F.ws + WS_KMEAN);
    if (dd >= 8 && dd < 16) return;
    float s1 = 0.f, s2 = 0.f; const float inv = dd < 8 ? moba_inv(dd) : 0.f;
    for (int t = 0; t < MBLK; ++t) { bf16* p = MK + ((size_t)b * SEQ + blk * MBLK + t) * 512 + head * MDH;
        if (dd < 8) { const float x1 = bf2f(p[dd]), x2 = bf2f(p[dd + 8]); const float ang = (float)(blk * MBLK + t) * inv; const float c = cosf(ang), s = sinf(ang);
            const float r1 = x1 * c - x2 * s, r2 = x1 * s + x2 * c; p[dd] = (bf16)f2bf(r1); p[dd + 8] = (bf16)f2bf(r2); s1 += r1; s2 += r2; }
        else s1 += bf2f(p[dd]); }
    float* km = KM + (((size_t)b * MH + head) * MNB + blk) * MDH;
    km[dd] = s1 * (1.f / MBLK); if (dd < 8) km[dd + 8] = s2 * (1.f / MBLK);
}
__device__ __forceinline__ void ret_scan(Frame& F) {
    bf16* ST = (bf16*)(F.ws + WS_ST);
    for (int u = F.bid * NTHR + F.tid; u < BATCH * RH * 4096; u += F.G * NTHR) { const int bh = u >> 12, off = (u & 4095) * 8;
        const float dec = exp2f(ret_log2g(bh & 3) * (float)RC);
        float st[8];
#pragma unroll
        for (int j = 0; j < 8; ++j) st[j] = 0.f;
        for (int n = 0; n < RNC; ++n) { v4u* p = (v4u*)(ST + ((size_t)(bh * RNC + n) * (RDV * RDK) + off)); const v4u w = *p;
            v4u o; o.x = pk2(st[0], st[1]); o.y = pk2(st[2], st[3]); o.z = pk2(st[4], st[5]); o.w = pk2(st[6], st[7]); *p = o;
            st[0] = dec * st[0] + bflo(w.x); st[1] = dec * st[1] + bfhi(w.x); st[2] = dec * st[2] + bflo(w.y); st[3] = dec * st[3] + bfhi(w.y);
            st[4] = dec * st[4] + bflo(w.z); st[5] = dec * st[5] + bfhi(w.z); st[6] = dec * st[6] + bflo(w.w); st[7] = dec * st[7] + bfhi(w.w); } }
}
constexpr int QP = 136;
__device__ __forceinline__ void ret_out_item(Frame& F, int item) {
    const int n = item & 15, h = (item >> 4) & 3, b = item >> 6, tid = F.tid;
    const size_t row0 = (size_t)b * SEQ + n * RC;
    const bf16* RQ = (const bf16*)(F.ws + WS_RQ); const bf16* RK = (const bf16*)(F.ws + WS_RK); const bf16* RV = (const bf16*)(F.ws + WS_RV);
    bf16* SG = (bf16*)(F.ws + WS_SG); const bf16* ST = (const bf16*)(F.ws + WS_ST);
    LAS bf16* Qb = (LAS bf16*)F.lds; LAS bf16* Kb = (LAS bf16*)(F.lds + RC * QP * 2); LAS bf16* Vb = (LAS bf16*)F.lds; LAS float* S = (LAS float*)(F.lds + 2 * RC * QP * 2);
    const float lg2 = ret_log2g(h);
    for (int idx = tid; idx < RC * 64; idx += NTHR) { const int k = idx >> 6, i = idx & 63;
        const bf16* qr = RQ + (row0 + k) * 512 + h * RDK; const bf16* kr = RK + (row0 + k) * 512 + h * RDK;
        const float q1 = bf2f(qr[i]), q2 = bf2f(qr[i + 64]), k1 = bf2f(kr[i]), k2 = bf2f(kr[i + 64]);
        const float ang = (float)(n * RC + k) * ret_inv(i); const float c = cosf(ang), s = sinf(ang);
        Qb[k * QP + i] = (bf16)f2bf(q1 * c - q2 * s); Qb[k * QP + i + 64] = (bf16)f2bf(q1 * s + q2 * c);
        Kb[k * QP + i] = (bf16)f2bf((k1 * c - k2 * s) * 0.08838834764831845f); Kb[k * QP + i + 64] = (bf16)f2bf((k1 * s + k2 * c) * 0.08838834764831845f); }
    __syncthreads();
    const int c = tid >> 2, eg = tid & 3;
#pragma unroll 1
    for (int j = 0; j < 32; ++j) { const int k = eg + 4 * j; float dot = 0.f;
        if (k <= c) {
#pragma unroll
            for (int d8 = 0; d8 < 16; ++d8) { const v4u a = *(const LAS v4u*)(Qb + c * QP + d8 * 8), w = *(const LAS v4u*)(Kb + k * QP + d8 * 8);
                dot += bflo(a.x) * bflo(w.x) + bfhi(a.x) * bfhi(w.x) + bflo(a.y) * bflo(w.y) + bfhi(a.y) * bfhi(w.y) + bflo(a.z) * bflo(w.z) + bfhi(a.z) * bfhi(w.z) + bflo(a.w) * bflo(w.w) + bfhi(a.w) * bfhi(w.w); }
            dot *= exp2f(lg2 * (float)(c - k)); }
        S[c * 129 + k] = dot; }
    float acc[64];
#pragma unroll
    for (int i = 0; i < 64; ++i) acc[i] = 0.f;
    const bf16* stp = ST + ((size_t)item * RDV + eg * 64) * RDK;
#pragma unroll 1
    for (int d8 = 0; d8 < 16; ++d8) { const v4u a = *(const LAS v4u*)(Qb + c * QP + d8 * 8);
        const float q0 = bflo(a.x), q1 = bfhi(a.x), q2 = bflo(a.y), q3 = bfhi(a.y), q4 = bflo(a.z), q5 = bfhi(a.z), q6 = bflo(a.w), q7 = bfhi(a.w);
#pragma unroll
        for (int i8 = 0; i8 < 8; ++i8) {
#pragma unroll
            for (int ii = 0; ii < 8; ++ii) { const int i = i8 * 8 + ii; const v4u w = *(const v4u*)(stp + (size_t)i * RDK + d8 * 8);
                acc[i] += q0 * bflo(w.x) + q1 * bfhi(w.x) + q2 * bflo(w.y) + q3 * bfhi(w.y) + q4 * bflo(w.z) + q5 * bfhi(w.z) + q6 * bflo(w.w) + q7 * bfhi(w.w); }
            asm volatile("" ::: "memory"); } }
    { const float qd = exp2f(lg2 * (float)(c + 1));
#pragma unroll
      for (int i = 0; i < 64; ++i) acc[i] *= qd; }
    __syncthreads();
    for (int idx = tid; idx < RC * 32; idx += NTHR) { const int k = idx >> 5, ch = idx & 31;
        *(LAS v4u*)(Vb + k * RDV + ch * 8) = *(const v4u*)(RV + (row0 + k) * 1024 + h * RDV + ch * 8); }
    __syncthreads();
#pragma unroll 1
    for (int k = 0; k <= c; ++k) { const float sv = S[c * 129 + k];
#pragma unroll
        for (int c8 = 0; c8 < 8; ++c8) { const v4u w = *(const LAS v4u*)(Vb + k * RDV + eg * 64 + c8 * 8);
            acc[c8 * 8 + 0] += sv * bflo(w.x); acc[c8 * 8 + 1] += sv * bfhi(w.x); acc[c8 * 8 + 2] += sv * bflo(w.y); acc[c8 * 8 + 3] += sv * bfhi(w.y);
            acc[c8 * 8 + 4] += sv * bflo(w.z); acc[c8 * 8 + 5] += sv * bfhi(w.z); acc[c8 * 8 + 6] += sv * bflo(w.w); acc[c8 * 8 + 7] += sv * bfhi(w.w); } }
    float s = 0.f;
#pragma unroll
    for (int i = 0; i < 64; ++i) s += acc[i];
    s += __shfl_xor(s, 1); s += __shfl_xor(s, 2);
    const float mean = s * (1.f / RDV); float q = 0.f;
#pragma unroll
    for (int i = 0; i < 64; ++i) { acc[i] -= mean; q += acc[i] * acc[i]; }
    q += __shfl_xor(q, 1); q += __shfl_xor(q, 2);
    const float rstd = 1.0f / sqrtf(q * (1.f / RDV) + GN_EPS);
    bf16* yp = SG + (row0 + c) * 1024 + h * RDV + eg * 64;
#pragma unroll
    for (int c8 = 0; c8 < 8; ++c8) { const v4u g = *(const v4u*)(yp + c8 * 8); v4u o;
        o.x = pk2(acc[c8 * 8 + 0] * rstd * bflo(g.x), acc[c8 * 8 + 1] * rstd * bfhi(g.x)); o.y = pk2(acc[c8 * 8 + 2] * rstd * bflo(g.y), acc[c8 * 8 + 3] * rstd * bfhi(g.y));
        o.z = pk2(acc[c8 * 8 + 4] * rstd * bflo(g.z), acc[c8 * 8 + 5] * rstd * bfhi(g.z)); o.w = pk2(acc[c8 * 8 + 6] * rstd * bflo(g.w), acc[c8 * 8 + 7] * rstd * bfhi(g.w));
        *(v4u*)(yp + c8 * 8) = o; }
    __syncthreads();
}
__device__ __forceinline__ void moba_item(Frame& F, int item) {
    const int q512 = item & 3, h = (item >> 2) & 7, b = item >> 5;
    const int s = q512 * 512 + F.tid, cur = s >> 8;
    bf16* MQ = (bf16*)(F.ws + WS_MQ); const bf16* MK = (const bf16*)(F.ws + WS_MK); const bf16* MV = (const bf16*)(F.ws + WS_MV); const float* KM = (const float*)(F.ws + WS_KMEAN);
    bf16* qp = MQ + ((size_t)b * SEQ + s) * 512 + h * MDH;
    float q[64];
#pragma unroll
    for (int c8 = 0; c8 < 8; ++c8) { const v4u w = *(const v4u*)(qp + c8 * 8);
        q[c8 * 8 + 0] = bflo(w.x); q[c8 * 8 + 1] = bfhi(w.x); q[c8 * 8 + 2] = bflo(w.y); q[c8 * 8 + 3] = bfhi(w.y); q[c8 * 8 + 4] = bflo(w.z); q[c8 * 8 + 5] = bfhi(w.z); q[c8 * 8 + 6] = bflo(w.w); q[c8 * 8 + 7] = bfhi(w.w); }
#pragma unroll
    for (int i = 0; i < 8; ++i) { const float ang = (float)s * moba_inv(i); const float c = cosf(ang), sn = sinf(ang); const float x1 = q[i], x2 = q[i + 8]; q[i] = x1 * c - x2 * sn; q[i + 8] = x1 * sn + x2 * c; }
    int s0 = -1, s1 = -1, s2 = -1; float g0 = -INFINITY, g1 = -INFINITY, g2 = -INFINITY;
#pragma unroll
    for (int nb = 0; nb < 7; ++nb) if (nb < cur) { const float* km = KM + (((size_t)b * MH + h) * MNB + nb) * MDH; float g = 0.f;
#pragma unroll
        for (int d = 0; d < 64; ++d) g += q[d] * km[d];
        if (g > g0) { g2 = g1; s2 = s1; g1 = g0; s1 = s0; g0 = g; s0 = nb; } else if (g > g1) { g2 = g1; s2 = s1; g1 = g; s1 = nb; } else if (g > g2) { g2 = g; s2 = nb; } }
#pragma unroll
    for (int d = 0; d < 64; ++d) q[d] *= 0.125f * 1.4426950408889634f;
    float mx = -1e30f, l = 0.f, o[64];
#pragma unroll
    for (int d = 0; d < 64; ++d) o[d] = 0.f;
#pragma unroll 1
    for (int j = 0; j < 4; ++j) { const int blk = j == 0 ? s0 : j == 1 ? s1 : j == 2 ? s2 : cur; if (blk < 0) continue;
        const int nk = j == 3 ? (s & 255) + 1 : MBLK;
        const bf16* kb = MK + ((size_t)b * SEQ + blk * MBLK) * 512 + h * MDH; const bf16* vb = MV + ((size_t)b * SEQ + blk * MBLK) * 512 + h * MDH;
#pragma unroll 1
        for (int p = 0; p < nk; ++p) { float sc = 0.f;
#pragma unroll
            for (int c8 = 0; c8 < 8; ++c8) { const v4u w = *(const v4u*)(kb + (size_t)p * 512 + c8 * 8);
                sc += q[c8 * 8 + 0] * bflo(w.x) + q[c8 * 8 + 1] * bfhi(w.x) + q[c8 * 8 + 2] * bflo(w.y) + q[c8 * 8 + 3] * bfhi(w.y) + q[c8 * 8 + 4] * bflo(w.z) + q[c8 * 8 + 5] * bfhi(w.z) + q[c8 * 8 + 6] * bflo(w.w) + q[c8 * 8 + 7] * bfhi(w.w); }
            const float mn = fmaxf(mx, sc), a = exp2f(mx - mn), pw = exp2f(sc - mn); l = l * a + pw; mx = mn;
#pragma unroll
            for (int c8 = 0; c8 < 8; ++c8) { const v4u w = *(const v4u*)(vb + (size_t)p * 512 + c8 * 8);
                o[c8 * 8 + 0] = o[c8 * 8 + 0] * a + pw * bflo(w.x); o[c8 * 8 + 1] = o[c8 * 8 + 1] * a + pw * bfhi(w.x); o[c8 * 8 + 2] = o[c8 * 8 + 2] * a + pw * bflo(w.y); o[c8 * 8 + 3] = o[c8 * 8 + 3] * a + pw * bfhi(w.y);
                o[c8 * 8 + 4] = o[c8 * 8 + 4] * a + pw * bflo(w.z); o[c8 * 8 + 5] = o[c8 * 8 + 5] * a + pw * bfhi(w.z); o[c8 * 8 + 6] = o[c8 * 8 + 6] * a + pw * bflo(w.w); o[c8 * 8 + 7] = o[c8 * 8 + 7] * a + pw * bfhi(w.w); } } }
    const float il = 1.0f / l;
#pragma unroll
    for (int c8 = 0; c8 < 8; ++c8) { v4u w; w.x = pk2(o[c8 * 8 + 0] * il, o[c8 * 8 + 1] * il); w.y = pk2(o[c8 * 8 + 2] * il, o[c8 * 8 + 3] * il); w.z = pk2(o[c8 * 8 + 4] * il, o[c8 * 8 + 5] * il); w.w = pk2(o[c8 * 8 + 6] * il, o[c8 * 8 + 7] * il);
        *(v4u*)(qp + c8 * 8) = w; }
}

constexpr int N_PHASES = 15;
__global__ void __launch_bounds__(NTHR, 2) fwd_kernel(Args args) {
    extern __shared__ __attribute__((aligned(16))) unsigned char lds[];
    Frame F;
    F.lds = (LAS unsigned char*)lds; F.tid = threadIdx.x; F.lane = F.tid & 63; F.wave = __builtin_amdgcn_readfirstlane(F.tid >> 6);
    F.G = gridDim.x; F.bid = blockIdx.x; F.x = args.in[0]; F.out = args.out; F.ws = args.ws;
    unsigned char* ws = args.ws;
    const int gw = F.bid * NWAVES + F.wave, NGW = F.G * NWAVES;
    const int lo = args.ph_lo, hi = args.ph_hi;
#ifndef PHASE_MASK
#define PHASE_MASK 0x7fff
#endif
#define IN(k) (((PHASE_MASK >> (k)) & 1) && lo <= (k) && (k) < hi)
#if MK_SINGLE
#define SEAM(k) do { if (IN(k) && IN((k) + 1)) cg::this_grid().sync(); } while (0)
#else
#define SEAM(k) do { } while (0)
#endif
    bf16* XNB = (bf16*)(ws + WS_XNB); bf16* HB = (bf16*)(ws + WS_H);
    if (IN(0)) {
        transpose_gu(F, args.in[3], (bf16*)(ws + WS_WGU1), gw, NGW);
        transpose_plain(F, args.in[4], FF, D, (bf16*)(ws + WS_WD1), gw, NGW);
        transpose_plain(F, args.in[5], D, NIN, (bf16*)(ws + WS_WIN), gw, NGW);
        transpose_plain(F, args.in[6], D, D, (bf16*)(ws + WS_WRP), gw, NGW);
        transpose_plain(F, args.in[7], 512, D, (bf16*)(ws + WS_WMP), gw, NGW);
        transpose_plain(F, args.in[8], D, D, (bf16*)(ws + WS_WOUT), gw, NGW);
        cvt_rows(F, F.x, XNB, gw, NGW);
        __syncthreads();
    }
    SEAM(0);
    if (IN(1)) { pg8::Gemm g{XNB, (const bf16*)(ws + WS_WGU1), M, NGU, D}; pg8::StaticOrder S; S.init(M, NGU, F.G, F.bid);
        pg8::EpiSwiGLU E{HB, FF}; pg8::gemm_phase<pg8::EpiSwiGLU, pg8::StaticOrder, PG8_ALIGN, PG8_SP2>(F.lds, g, S, E); }
    SEAM(1);
    if (IN(2)) { pg8::Gemm g{HB, (const bf16*)(ws + WS_WD1), M, D, FF}; pg8::StaticOrder S; S.init(M, D, F.G, F.bid);
        pg8::EpiResid E{F.x, F.out, D, ALPHA, 0.5f}; pg8::gemm_phase<pg8::EpiResid, pg8::StaticOrder, PG8_ALIGN, PG8_SP2>(F.lds, g, S, E); }
    SEAM(2);
    if (IN(3)) { ln_rows(F, F.out, XNB, args.in[1], args.in[2], gw, NGW); }
    SEAM(3);
    if (IN(4)) { pg8::Gemm g{XNB, (const bf16*)(ws + WS_WIN), M, NIN, D}; pg8::StaticOrder S; S.init(M, NIN, F.G, F.bid);
        pg8::EpiProj E{(bf16*)(ws + WS_RQ), (bf16*)(ws + WS_RK), (bf16*)(ws + WS_RV), (bf16*)(ws + WS_SG), (bf16*)(ws + WS_MQ), (bf16*)(ws + WS_MK), (bf16*)(ws + WS_MV), (bf16*)(ws + WS_GT)};
        pg8::gemm_phase<pg8::EpiProj, pg8::StaticOrder, PG8_ALIGN, PG8_SP2>(F.lds, g, S, E); }
    SEAM(4);
    if (IN(5)) {
        for (int it = F.bid; it < BATCH * MNB; it += F.G) moba_kprep_item(F, it);
        for (int it = F.bid; it < BATCH * RH * RNC; it += F.G) ret_kv_item(F, it);
    }
    SEAM(5);
    if (IN(6)) { ret_scan(F); }
    SEAM(6);
    if (IN(7)) {
        for (int it = F.bid; it < BATCH * RH * RNC; it += F.G) ret_out_item(F, it);
        for (int it = F.bid; it < BATCH * MH * 4; it += F.G) moba_item(F, it);
    }
    SEAM(7);
    if (IN(8)) { pg8::Gemm g{(const bf16*)(ws + WS_SG), (const bf16*)(ws + WS_WRP), M, D, D}; pg8::StaticOrder S; S.init(M, D, F.G, F.bid);
        pg8::EpiGateA E{(const bf16*)(ws + WS_GT), (float*)(ws + WS_T)}; pg8::gemm_phase<pg8::EpiGateA, pg8::StaticOrder, PG8_ALIGN, PG8_SP2>(F.lds, g, S, E); }
    SEAM(8);
    if (IN(9)) { pg8::Gemm g{(const bf16*)(ws + WS_MQ), (const bf16*)(ws + WS_WMP), M, D, 512}; pg8::StaticOrder S; S.init(M, D, F.G, F.bid);
        pg8::EpiGateB E{(const bf16*)(ws + WS_GT), (const float*)(ws + WS_T), (bf16*)(ws + WS_Z)}; pg8::gemm_phase<pg8::EpiGateB, pg8::StaticOrder, PG8_ALIGN, PG8_SP2>(F.lds, g, S, E); }
    SEAM(9);
    if (IN(10)) {
        transpose_gu(F, args.in[11], (bf16*)(ws + WS_WGU2), gw, NGW);
        transpose_plain(F, args.in[12], FF, D, (bf16*)(ws + WS_WD2), gw, NGW);
        __syncthreads();
        pg8::Gemm g{(const bf16*)(ws + WS_Z), (const bf16*)(ws + WS_WOUT), M, D, D}; pg8::StaticOrder S; S.init(M, D, F.G, F.bid);
        pg8::EpiResid E{F.out, F.out, D, ALPHA, 1.0f}; pg8::gemm_phase<pg8::EpiResid, pg8::StaticOrder, PG8_ALIGN, PG8_SP2>(F.lds, g, S, E); }
    SEAM(10);
    if (IN(11)) { ln_rows(F, F.out, XNB, args.in[9], args.in[10], gw, NGW); }
    SEAM(11);
    if (IN(12)) { pg8::Gemm g{XNB, (const bf16*)(ws + WS_WGU2), M, NGU, D}; pg8::StaticOrder S; S.init(M, NGU, F.G, F.bid);
        pg8::EpiSwiGLU E{HB, FF}; pg8::gemm_phase<pg8::EpiSwiGLU, pg8::StaticOrder, PG8_ALIGN, PG8_SP2>(F.lds, g, S, E); }
    SEAM(12);
    if (IN(13)) { pg8::Gemm g{HB, (const bf16*)(ws + WS_WD2), M, D, FF}; pg8::StaticOrder S; S.init(M, D, F.G, F.bid);
        pg8::EpiResid E{F.out, F.out, D, ALPHA, 0.5f}; pg8::gemm_phase<pg8::EpiResid, pg8::StaticOrder, PG8_ALIGN, PG8_SP2>(F.lds, g, S, E); }
    SEAM(13);
    if (IN(14)) { ln_rows(F, F.out, nullptr, args.in[13], args.in[14], gw, NGW); }
#undef IN
#undef SEAM
}

extern "C" void kernel_launch(void* const* d_in, const int* in_sizes, int n_in, void* d_out, int out_size, void* d_ws, size_t ws_size, hipStream_t stream) {
    static int grid = 0;
    if (grid == 0) {
        if (n_in != 15 || out_size != M * D || ws_size < WS_END) { fprintf(stderr, "kernel_launch: unexpected shapes (n_in %d out %d ws %zu)\n", n_in, out_size, ws_size); grid = -1; return; }
        int dev = 0, cus = 0, per_cu = 0;
        hipGetDevice(&dev); hipDeviceGetAttribute(&cus, hipDeviceAttributeMultiprocessorCount, dev);
        if (hipFuncSetAttribute((const void*)fwd_kernel, hipFuncAttributeMaxDynamicSharedMemorySize, LDS_BYTES) != hipSuccess) { fprintf(stderr, "hipFuncSetAttribute failed\n"); grid = -1; return; }
        hipOccupancyMaxActiveBlocksPerMultiprocessor(&per_cu, (const void*)fwd_kernel, NTHR, LDS_BYTES);
        (void)hipGetLastError();
        if (per_cu < 1) { fprintf(stderr, "occupancy query says %d blocks per CU\n", per_cu); grid = -1; return; }
        grid = cus;
    }
    if (grid < 0) return;
    Args a{};
    for (int i = 0; i < 15; ++i) a.in[i] = (const float*)d_in[i];
    a.out = (float*)d_out; a.ws = (unsigned char*)d_ws;
#if MK_SINGLE
    a.ph_lo = 0; a.ph_hi = N_PHASES;
    void* kargs[] = {&a};
    hipError_t e = hipLaunchCooperativeKernel((const void*)fwd_kernel, dim3(grid), dim3(NTHR), kargs, LDS_BYTES, stream);
    if (e != hipSuccess) fprintf(stderr, "cooperative launch failed: %s (grid %d)\n", hipGetErrorString(e), grid);
#else
    for (int p = 0; p < N_PHASES; ++p) { a.ph_lo = p; a.ph_hi = p + 1; hipLaunchKernelGGL(fwd_kernel, dim3(grid), dim3(NTHR), LDS_BYTES, stream, a); }
#endif
}
```

```cpp
#include <hip/hip_runtime.h>
#include <hip/hip_cooperative_groups.h>
#include <cstdio>
#include <cstdint>
__device__ __forceinline__ int tid_from(int wave_sgpr) { int w = wave_sgpr; unsigned m = ~0u; asm volatile("" : "+s"(w), "+s"(m)); const int l = __builtin_amdgcn_mbcnt_hi(m, __builtin_amdgcn_mbcnt_lo(m, 0u)); return w * 64 + l; }
namespace pg8 {
#define PG8_LAS __attribute__((address_space(3)))
typedef unsigned short bf16_t;
typedef short bf16x8 __attribute__((ext_vector_type(8)));
typedef float f32x4 __attribute__((ext_vector_type(4)));
typedef unsigned u32x4 __attribute__((ext_vector_type(4)));
constexpr int BM = 256, BK = 64, HALF = 128, HTB = HALF * BK * 2  , STAGE_BYTES = 8 * HTB, NXCD = 8, WGM = 8;

__host__ __device__ __forceinline__ int lds_byte(int r, int c) { const int st = (r >> 4) * 2 + (c >> 5), rr = r & 15, cc = c & 31, ob = rr * 64 + cc * 2; return st * 1024 + (ob ^ (((ob >> 9) & 1) << 5)); }
__host__ __device__ __forceinline__ void stage_rc(int b, int& R, int& C) { const int st = b / 1024, sb = b % 1024, swz = sb ^ (((sb >> 9) & 1) << 5); R = (st >> 1) * 16 + swz / 64; C = (st & 1) * 32 + (swz % 64) / 2; }
__host__ __device__ __forceinline__ int perm32(int rho) { const int n = rho >> 4, i = rho & 15; return 8 * (i >> 2) + 4 * n + (i & 3); }

struct Unit { int pm, pn; };
struct Gemm { const bf16_t* A; const bf16_t* Bt; int M, N, K; };

struct StaticOrder {
    int nM, nN, nwg, G, c;
    __host__ __device__ void init(int M, int N, int G_, int c_) { nM = M / BM; nN = N / BM; nwg = nM * nN; G = G_; c = c_; }
    __host__ __device__ bool next(int i, Unit& u) const {
        const long L = (long)i * G + c; if (L >= nwg) return false;
        int wgid = (int)L; { const int q = nwg / NXCD, r = nwg % NXCD, xcd = wgid % NXCD, off = wgid / NXCD; wgid = (xcd < r ? xcd * (q + 1) : r * (q + 1) + (xcd - r) * q) + off; }
        const int nig = WGM * nN, gid = wgid / nig, fm = gid * WGM, gsz = (nM - fm) < WGM ? (nM - fm) : WGM;
        u.pm = fm + ((wgid % nig) % gsz); u.pn = (wgid % nig) / gsz; return true;
    }
    __device__ __forceinline__ void a_ready(const Unit&) const {}
    __device__ __forceinline__ void done(const Unit&) const {}
};

__device__ __forceinline__ unsigned cvt_pk_bf16(float lo, float hi) { unsigned r; asm volatile("v_cvt_pk_bf16_f32 %0, %1, %2" : "=v"(r) : "v"(lo), "v"(hi)); return r; }
typedef float f32x2 __attribute__((ext_vector_type(2)));
__device__ __forceinline__ f32x2 gelu_pk(f32x2 v) {
    const f32x2 av = __builtin_elementwise_abs(v), d = av * 0.2316418882f + 1.0f;
    f32x2 t; t.x = __builtin_amdgcn_rcpf(d.x); t.y = __builtin_amdgcn_rcpf(d.y);
    f32x2 q = t * 0.5307027145f + (-0.7265760135f); q = q * t + 0.7107068705f; q = q * t + (-0.142248368f); q = q * t + 0.127414796f; q = q * t;
    const f32x2 s = (v * v) * (-0.72134752044f);
    f32x2 e; e.x = __builtin_amdgcn_exp2f(s.x); e.y = __builtin_amdgcn_exp2f(s.y);
    const f32x2 m = v * (q * e), r = v - m;
    f32x2 o; o.x = v.x < 0.f ? m.x : r.x; o.y = v.y < 0.f ? m.y : r.y; return o;
}

template <int ACT  > struct EpiBf16 {
    static constexpr bool PERM = true, AFTER_DRAIN = false; static_assert(ACT == 0 || ACT == 1, "EpiBf16: ACT is 0 (none) or 1 (gelu_pk)");
    bf16_t* O; int ldc; const float* bias; int split_cols; size_t split_stride; float scale0;
    __device__ __forceinline__ void operator()(const f32x4 (&acc)[2][2][4][2], const Unit& u, int wr, int wc, int fr, int fq) const {
        const int row0 = u.pm * BM + wr * 64 + fr; int colt = u.pn * BM; bf16_t* base = O;
        float sc = 1.f; if (split_cols) { const int t = colt / split_cols; base += (size_t)t * split_stride; colt -= t * split_cols; if (t == 0) sc = scale0; }
        const int col0 = colt + wc * 32 + 8 * fq, bcol0 = u.pn * BM + wc * 32 + 8 * fq;
        f32x4 bv[2][2];
#pragma unroll
        for (int bj = 0; bj < 2; ++bj)
#pragma unroll
            for (int n = 0; n < 2; ++n) bv[bj][n] = bias ? *(const f32x4*)(bias + bcol0 + bj * HALF + 4 * n) : (f32x4){0.f, 0.f, 0.f, 0.f};
#pragma unroll
        for (int ai = 0; ai < 2; ++ai)
#pragma unroll
            for (int m = 0; m < 4; ++m) { bf16_t* rowp = base + (size_t)(row0 + ai * HALF + m * 16) * ldc + col0;
#pragma unroll
                for (int bj = 0; bj < 2; ++bj) { f32x4 v0 = acc[ai][bj][m][0] + bv[bj][0], v1 = acc[ai][bj][m][1] + bv[bj][1];
                    if (ACT == 1) { f32x2 a = gelu_pk((f32x2){v0[0], v0[1]}), b = gelu_pk((f32x2){v0[2], v0[3]}), c = gelu_pk((f32x2){v1[0], v1[1]}), d = gelu_pk((f32x2){v1[2], v1[3]});
                        v0 = (f32x4){a.x, a.y, b.x, b.y}; v1 = (f32x4){c.x, c.y, d.x, d.y}; }
                    v0 = v0 * sc; v1 = v1 * sc; u32x4 w; w.x = cvt_pk_bf16(v0[0], v0[1]); w.y = cvt_pk_bf16(v0[2], v0[3]); w.z = cvt_pk_bf16(v1[0], v1[1]); w.w = cvt_pk_bf16(v1[2], v1[3]);
                    *(u32x4*)(rowp + bj * HALF) = w; } }
    }
};

struct PanelStats {
    unsigned* xbuf;
    unsigned* cnt;
    unsigned* tmo;
    int ntn; float eps;
    unsigned code;
    __device__ __forceinline__ bool run(const f32x4 (&v)[2][2][4][2], const Unit& u, int wr, int wc, int fr, int fq, PG8_LAS unsigned char* lds, int wid, int lane) const {
        typedef float f32x2v __attribute__((ext_vector_type(2)));
        PG8_LAS f32x2v* P = (PG8_LAS f32x2v*)lds;
        PG8_LAS f32x2v* S = (PG8_LAS f32x2v*)(lds + 8192);
        PG8_LAS unsigned* flag = (PG8_LAS unsigned*)(lds + 8192 + 2048);
#pragma unroll
        for (int ai = 0; ai < 2; ++ai)
#pragma unroll
            for (int m = 0; m < 4; ++m) {
                float s = 0.f;
#pragma unroll
                for (int bj = 0; bj < 2; ++bj)
#pragma unroll
                    for (int n = 0; n < 2; ++n) { const f32x4 x = v[ai][bj][m][n]; s += (x[0] + x[1]) + (x[2] + x[3]); }
                s += __shfl_xor(s, 16); s += __shfl_xor(s, 32);
                const float mw = s * (1.0f / 64.0f); float q = 0.f;
#pragma unroll
                for (int bj = 0; bj < 2; ++bj)
#pragma unroll
                    for (int n = 0; n < 2; ++n) { const f32x4 d = v[ai][bj][m][n] - mw; q += (d[0] * d[0] + d[1] * d[1]) + (d[2] * d[2] + d[3] * d[3]); }
                q += __shfl_xor(q, 16); q += __shfl_xor(q, 32);
                if (fq == 0) P[(ai * HALF + wr * 64 + m * 16 + fr) * 4 + wc] = (f32x2v){mw, q};
            }
        asm volatile("s_waitcnt lgkmcnt(0)" ::: "memory"); __builtin_amdgcn_s_barrier(); asm volatile("" ::: "memory");
#if defined(BROKEN_EXCHANGE_NO_WAIT)
#warning BROKEN CONTROL BUILD: the row-statistics exchange does not wait; results are wrong by design
        if (blockIdx.x >= 64) { const long long t0_ = clock64(); while (clock64() - t0_ < 60000) __builtin_amdgcn_s_sleep(8); }
#endif
        const int row = wid * 32 + (lane & 31);
        if (lane < 32) {
            const f32x2v a = P[row * 4 + 0], b = P[row * 4 + 1], c = P[row * 4 + 2], d = P[row * 4 + 3];
            const float mt = (a.x + b.x + c.x + d.x) * 0.25f;
            const float da = a.x - mt, db = b.x - mt, dc = c.x - mt, dd = d.x - mt;
            const float m2 = (a.y + b.y) + (c.y + d.y) + 64.0f * ((da * da + db * db) + (dc * dc + dd * dd));
            unsigned long long* slot = (unsigned long long*)xbuf + ((size_t)(u.pm * BM + row) * 4 + u.pn);
            __hip_atomic_store(slot, ((unsigned long long)__float_as_uint(m2) << 32) | __float_as_uint(mt), __ATOMIC_RELAXED, __HIP_MEMORY_SCOPE_AGENT);
        }
        asm volatile("s_waitcnt vmcnt(0)" ::: "memory");
        if (lane == 0) __hip_atomic_fetch_add(cnt + 64 * u.pm, 1u, __ATOMIC_RELAXED, __HIP_MEMORY_SCOPE_AGENT);
        if (wid == 0) {
            bool dead = false; const unsigned long long t0 = __builtin_amdgcn_s_memrealtime(); const unsigned want = 8u * (unsigned)ntn;
            for (;;) {
#if defined(BROKEN_EXCHANGE_NO_WAIT)
                break;
#endif
                if ((unsigned)__builtin_amdgcn_readfirstlane(__hip_atomic_load(cnt + 64 * u.pm, __ATOMIC_RELAXED, __HIP_MEMORY_SCOPE_AGENT)) >= want) break;
                if (__builtin_amdgcn_s_memrealtime() - t0 > 2000000ull) {
                    if (lane == 0) { unsigned expect = 0u; __hip_atomic_compare_exchange_strong(tmo + 1, &expect, code | (unsigned)(u.pm & 0xff), __ATOMIC_RELAXED, __ATOMIC_RELAXED, __HIP_MEMORY_SCOPE_AGENT);
                                     __hip_atomic_store(tmo, 1u, __ATOMIC_RELAXED, __HIP_MEMORY_SCOPE_AGENT); }
                    dead = true; break; }
                __builtin_amdgcn_s_sleep(2);
            }
            __builtin_amdgcn_fence(__ATOMIC_ACQUIRE, "agent");
            if (lane == 0) flag[0] = dead ? 1u : 0u;
        }
        asm volatile("s_waitcnt vmcnt(0) lgkmcnt(0)" ::: "memory"); __builtin_amdgcn_s_barrier(); asm volatile("" ::: "memory");
        const bool bad = flag[0] != 0u;
        if (lane < 32) {
            const unsigned long long* slot = (const unsigned long long*)xbuf + (size_t)(u.pm * BM + row) * 4; float mt[4], m2[4]; float ms = 0.f;
#pragma unroll
            for (int t = 0; t < 4; ++t) { if (t < ntn) { const unsigned long long w = __hip_atomic_load(slot + t, __ATOMIC_RELAXED, __HIP_MEMORY_SCOPE_AGENT); mt[t] = __uint_as_float((unsigned)w); m2[t] = __uint_as_float((unsigned)(w >> 32)); } else { mt[t] = 0.f; m2[t] = 0.f; } ms += mt[t]; }
            const float mean = ms / (float)ntn; float q = 0.f;
#pragma unroll
            for (int t = 0; t < 4; ++t) if (t < ntn) { const float dm = mt[t] - mean; q += m2[t] + 256.0f * dm * dm; }
            S[row] = (f32x2v){mean, 1.0f / sqrtf(q / (256.0f * (float)ntn) + eps)};
        }
        asm volatile("s_waitcnt lgkmcnt(0)" ::: "memory"); __builtin_amdgcn_s_barrier(); asm volatile("" ::: "memory");
        return bad;
    }
};
struct EpiLnRes {
    static constexpr bool PERM = false, AFTER_DRAIN = true;
    const float* base; float* out; int ldc; const float* bias; PanelStats st; unsigned poison;
    __device__ __forceinline__ void fused(f32x4 (&acc)[2][2][4][2], const Unit& u, int wr, int wc, int fr, int fq, PG8_LAS unsigned char* lds, int wid, int lane) const {
        typedef float f32x2v __attribute__((ext_vector_type(2)));
        const PG8_LAS f32x2v* S = (const PG8_LAS f32x2v*)(lds + 8192);
        const int col0 = u.pn * BM + wc * 32 + 4 * fq;
#pragma unroll
        for (int bj = 0; bj < 2; ++bj)
#pragma unroll
            for (int n = 0; n < 2; ++n) { const f32x4 bv = bias ? *(const f32x4*)(bias + col0 + bj * HALF + n * 16) : (f32x4){0.f, 0.f, 0.f, 0.f};
#pragma unroll
                for (int ai = 0; ai < 2; ++ai)
#pragma unroll
                    for (int m = 0; m < 4; ++m) acc[ai][bj][m][n] += bv; }
        f32x4 pre[4][2][2];
#pragma unroll
        for (int m = 0; m < 4; ++m) { const size_t off = (size_t)(u.pm * BM + wr * 64 + m * 16 + fr) * ldc + col0;
#pragma unroll
            for (int bj = 0; bj < 2; ++bj)
#pragma unroll
                for (int n = 0; n < 2; ++n) pre[m][bj][n] = *(const f32x4*)(base + off + bj * HALF + n * 16); }
        const bool bad = st.run(acc, u, wr, wc, fr, fq, lds, wid, lane) || poison != 0u;
        const float qnan = __builtin_nanf("");
#pragma unroll
        for (int ai = 0; ai < 2; ++ai)
#pragma unroll
            for (int m = 0; m < 4; ++m) { const int r = ai * HALF + wr * 64 + m * 16 + fr; const f32x2v sr = S[r]; const size_t off = (size_t)(u.pm * BM + r) * ldc + col0;
#pragma unroll
                for (int bj = 0; bj < 2; ++bj)
#pragma unroll
                    for (int n = 0; n < 2; ++n) { const f32x4 bs = ai == 0 ? pre[m][bj][n] : *(const f32x4*)(base + off + bj * HALF + n * 16); f32x4 o = bs + (acc[ai][bj][m][n] - sr.x) * sr.y;
                        if (bad) o = (f32x4){qnan, qnan, qnan, qnan}; *(f32x4*)(out + off + bj * HALF + n * 16) = o; }
                if (m & 1) asm volatile("" ::: "memory"); }
    }
};
struct EpiLnResLn {
    static constexpr bool PERM = false, AFTER_DRAIN = true;
    const float* base; float* out; bf16_t* xn; int ldc; const float* bias; PanelStats st1, st2; unsigned poison;
    __device__ __forceinline__ void fused(f32x4 (&acc)[2][2][4][2], const Unit& u, int wr, int wc, int fr, int fq, PG8_LAS unsigned char* lds, int wid, int lane) const {
        typedef float f32x2v __attribute__((ext_vector_type(2))); typedef unsigned u32x2v __attribute__((ext_vector_type(2)));
        const PG8_LAS f32x2v* S = (const PG8_LAS f32x2v*)(lds + 8192);
        const int col0 = u.pn * BM + wc * 32 + 4 * fq;
#pragma unroll
        for (int bj = 0; bj < 2; ++bj)
#pragma unroll
            for (int n = 0; n < 2; ++n) { const f32x4 bv = bias ? *(const f32x4*)(bias + col0 + bj * HALF + n * 16) : (f32x4){0.f, 0.f, 0.f, 0.f};
#pragma unroll
                for (int ai = 0; ai < 2; ++ai)
#pragma unroll
                    for (int m = 0; m < 4; ++m) acc[ai][bj][m][n] += bv; }
        bool bad = st1.run(acc, u, wr, wc, fr, fq, lds, wid, lane) || poison != 0u;
        const float qnan = __builtin_nanf("");
#pragma unroll
        for (int ai = 0; ai < 2; ++ai)
#pragma unroll
            for (int m = 0; m < 4; ++m) { const int r = ai * HALF + wr * 64 + m * 16 + fr; const f32x2v sr = S[r]; const size_t off = (size_t)(u.pm * BM + r) * ldc + col0;
#pragma unroll
                for (int bj = 0; bj < 2; ++bj)
#pragma unroll
                    for (int n = 0; n < 2; ++n) { const f32x4 bs = *(const f32x4*)(base + off + bj * HALF + n * 16); acc[ai][bj][m][n] = bs + (acc[ai][bj][m][n] - sr.x) * sr.y; }
                asm volatile("" : "+v"(acc[ai][0][m][0]), "+v"(acc[ai][0][m][1]), "+v"(acc[ai][1][m][0]), "+v"(acc[ai][1][m][1]));
                if (m & 1) asm volatile("" ::: "memory"); }
        const bool bad1 = bad;
        bad = st2.run(acc, u, wr, wc, fr, fq, lds, wid, lane) || bad;
#pragma unroll
        for (int ai = 0; ai < 2; ++ai)
#pragma unroll
            for (int m = 0; m < 4; ++m) { const int r = ai * HALF + wr * 64 + m * 16 + fr; const f32x2v sr = S[r]; const size_t off = (size_t)(u.pm * BM + r) * ldc + col0;
#pragma unroll
                for (int bj = 0; bj < 2; ++bj)
#pragma unroll
                    for (int n = 0; n < 2; ++n) { const f32x4 x1 = acc[ai][bj][m][n]; *(f32x4*)(out + off + bj * HALF + n * 16) = bad1 ? (f32x4){qnan, qnan, qnan, qnan} : x1;
                        const f32x4 o = (x1 - sr.x) * sr.y; u32x2v w; w.x = cvt_pk_bf16(o[0], o[1]); w.y = cvt_pk_bf16(o[2], o[3]);
                        if (bad) { w.x = 0x7fc07fc0u; w.y = 0x7fc07fc0u; } *(u32x2v*)(xn + off + bj * HALF + n * 16) = w; }
                asm volatile("" ::: "memory"); }
    }
};

template <class Epi, class Sched, bool ALIGN_EPI = false, bool SP2 = false>
__device__ __forceinline__ void gemm_phase(PG8_LAS unsigned char* lds, const Gemm g, const Sched& S, const Epi& E, int wave_id) {
    const int tid = tid_from(wave_id), wid = __builtin_amdgcn_readfirstlane(tid >> 6), lane = tid & 63, wr = wid >> 2, wc = wid & 3, fr = lane & 15, fq = lane >> 4;
    const int K = g.K, nt = K / BK;
    unsigned voffA[2], voffB[2];
#pragma unroll
    for (int i = 0; i < 2; ++i) { int R, C; stage_rc(tid * 16 + i * 8192, R, C); const int Rb = Epi::PERM ? ((R & ~31) + perm32(R & 31)) : R;
        voffA[i] = (unsigned)(R * K + C) * 2u; voffB[i] = (unsigned)(Rb * K + C) * 2u; }
    const size_t kstep = (size_t)(BK * 2);
    const size_t hstep = (size_t)HALF * K * 2;
    const size_t tstep = 2 * hstep;
    const unsigned ldsw = (unsigned)wid * 1024u;
    const int aoff = lds_byte(wr * 64 + fr, fq * 8), boff = lds_byte(wc * 32 + fr, fq * 8);
#define PG8_SA(b, h) (((b) * 2 + (h)) * HTB)
#define PG8_SB(b, h) ((4 + (b) * 2 + (h)) * HTB)
#define PG8_STAGE(bufoff, gbase, voff) do { _Pragma("unroll") for (int _i = 0; _i < 2; ++_i) \
        __builtin_amdgcn_global_load_lds((const unsigned*)((const char*)(gbase) + (voff)[_i]), (PG8_LAS unsigned*)(lds + (bufoff) + ldsw + _i * 8192), 16, 0, 0); } while (0)
#define PG8_LDA(dst, b, h) do { _Pragma("unroll") for (int m = 0; m < 4; ++m) _Pragma("unroll") for (int k = 0; k < 2; ++k) dst[m][k] = *(const PG8_LAS bf16x8*)(lds + PG8_SA(b, h) + aoff + m * 2048 + k * 1024); } while (0)
#define PG8_LDB(dst, b, h) do { _Pragma("unroll") for (int n = 0; n < 2; ++n) _Pragma("unroll") for (int k = 0; k < 2; ++k) dst[n][k] = *(const PG8_LAS bf16x8*)(lds + PG8_SB(b, h) + boff + n * 2048 + k * 1024); } while (0)
#define PG8_MMA(ai, bj, At, Bt) do { __builtin_amdgcn_s_setprio(1); _Pragma("unroll") for (int m = 0; m < 4; ++m) _Pragma("unroll") for (int n = 0; n < 2; ++n) _Pragma("unroll") for (int k = 0; k < 2; ++k) \
        acc[ai][bj][m][n] = __builtin_amdgcn_mfma_f32_16x16x32_bf16(Bt[n][k], At[m][k], acc[ai][bj][m][n], 0, 0, 0); __builtin_amdgcn_s_setprio(0); } while (0)
#define PG8_WAIT_V(n) asm volatile("s_waitcnt vmcnt(" #n ")" ::: "memory")
#define PG8_WAIT_L(n) asm volatile("s_waitcnt lgkmcnt(" #n ")" ::: "memory")
#define PG8_BAR __builtin_amdgcn_s_barrier()
#define PG8_SCHED __builtin_amdgcn_sched_barrier(0)
    Unit cur, nxt; int ui = 0;
    if (!S.next(0, cur)) return;
    f32x4 acc[2][2][4][2];
#pragma unroll
    for (int a = 0; a < 2; ++a)
#pragma unroll
        for (int b = 0; b < 2; ++b)
#pragma unroll
            for (int m = 0; m < 4; ++m)
#pragma unroll
                for (int n = 0; n < 2; ++n) acc[a][b][m][n] = (f32x4){0.f, 0.f, 0.f, 0.f};
    bf16x8 At[4][2], B0[2][2], B1[2][2];
    const char* cA = (const char*)g.A + (size_t)cur.pm * tstep; const char* cB = (const char*)g.Bt + (size_t)cur.pn * tstep;
    S.a_ready(cur);
    if constexpr (SP2) {
        PG8_STAGE(PG8_SB(0, 0), cB, voffB); PG8_STAGE(PG8_SB(0, 1), cB + hstep, voffB); PG8_STAGE(PG8_SA(0, 0), cA, voffA); PG8_STAGE(PG8_SA(0, 1), cA + hstep, voffA);
        if (wr == 1) PG8_BAR;
        PG8_WAIT_V(2); PG8_BAR;
        PG8_STAGE(PG8_SB(1, 0), cB + kstep, voffB); PG8_STAGE(PG8_SA(1, 0), cA + kstep, voffA); PG8_STAGE(PG8_SB(1, 1), cB + hstep + kstep, voffB);
        PG8_WAIT_V(6); PG8_BAR;
    } else {
        PG8_STAGE(PG8_SB(0, 0), cB, voffB); PG8_STAGE(PG8_SA(0, 0), cA, voffA); PG8_STAGE(PG8_SB(0, 1), cB + hstep, voffB); PG8_STAGE(PG8_SA(0, 1), cA + hstep, voffA);
        if (wr == 1) PG8_BAR;
        PG8_WAIT_V(4); PG8_BAR;
        PG8_STAGE(PG8_SB(1, 0), cB + kstep, voffB); PG8_STAGE(PG8_SA(1, 0), cA + kstep, voffA); PG8_STAGE(PG8_SB(1, 1), cB + hstep + kstep, voffB);
        PG8_WAIT_V(6); PG8_BAR;
    }
    for (;;) {
        const bool has_next = S.next(ui + 1, nxt);
        const char* nA = has_next ? (const char*)g.A + (size_t)nxt.pm * tstep : cA; const char* nB = has_next ? (const char*)g.Bt + (size_t)nxt.pn * tstep : cB;
        for (int t = 0; t < nt; t += 2) {
            const bool last = (t == nt - 2);
            const char* a1 = cA + (size_t)(t + 1) * kstep;
            const char* a2 = last ? nA : cA + (size_t)(t + 2) * kstep; const char* b2 = last ? nB : cB + (size_t)(t + 2) * kstep;
            const char* a3 = a2 + kstep; const char* b3 = b2 + kstep;
            if (last && has_next) S.a_ready(nxt);
            if constexpr (SP2) {
            PG8_LDB(B0, 0, 0); PG8_LDB(B1, 0, 1); PG8_SCHED; PG8_LDA(At, 0, 0); PG8_STAGE(PG8_SA(1, 1), a1 + hstep, voffA);
            PG8_WAIT_V(8); PG8_WAIT_L(0); PG8_BAR; PG8_MMA(0, 0, At, B0); PG8_MMA(0, 1, At, B1); PG8_BAR; PG8_SCHED;
            PG8_LDA(At, 0, 1); PG8_STAGE(PG8_SB(0, 0), b2, voffB); PG8_STAGE(PG8_SB(0, 1), b2 + hstep, voffB); PG8_STAGE(PG8_SA(0, 0), a2, voffA);
            PG8_WAIT_V(8); PG8_WAIT_L(0); PG8_BAR; PG8_MMA(1, 0, At, B0); PG8_MMA(1, 1, At, B1); PG8_BAR; PG8_SCHED;
            PG8_LDB(B0, 1, 0); PG8_LDB(B1, 1, 1); PG8_SCHED; PG8_LDA(At, 1, 0); PG8_STAGE(PG8_SA(0, 1), a2 + hstep, voffA);
            PG8_WAIT_V(8); PG8_WAIT_L(0); PG8_BAR; PG8_MMA(0, 0, At, B0); PG8_MMA(0, 1, At, B1); PG8_BAR; PG8_SCHED;
            PG8_LDA(At, 1, 1); PG8_STAGE(PG8_SB(1, 0), b3, voffB); PG8_STAGE(PG8_SB(1, 1), b3 + hstep, voffB); PG8_STAGE(PG8_SA(1, 0), a3, voffA);
            PG8_WAIT_V(8); PG8_WAIT_L(0); PG8_BAR; PG8_MMA(1, 0, At, B0); PG8_MMA(1, 1, At, B1); PG8_BAR; PG8_SCHED;
            } else {
            PG8_LDB(B0, 0, 0); PG8_SCHED; PG8_LDA(At, 0, 0); PG8_STAGE(PG8_SA(1, 1), a1 + hstep, voffA);
            PG8_WAIT_L(8); PG8_BAR; PG8_WAIT_L(0); PG8_MMA(0, 0, At, B0); PG8_BAR; PG8_SCHED;
            PG8_LDB(B1, 0, 1); PG8_STAGE(PG8_SB(0, 0), b2, voffB);
            PG8_BAR; PG8_WAIT_L(0); PG8_MMA(0, 1, At, B1); PG8_BAR;
            PG8_LDA(At, 0, 1); PG8_STAGE(PG8_SA(0, 0), a2, voffA);
            PG8_BAR; PG8_WAIT_L(0); PG8_MMA(1, 0, At, B0); PG8_BAR; PG8_SCHED;
            PG8_STAGE(PG8_SB(0, 1), b2 + hstep, voffB);
            PG8_WAIT_V(6); PG8_BAR; PG8_MMA(1, 1, At, B1); PG8_BAR;
            PG8_LDB(B0, 1, 0); PG8_SCHED; PG8_LDA(At, 1, 0); PG8_STAGE(PG8_SA(0, 1), a2 + hstep, voffA);
            PG8_WAIT_L(8); PG8_BAR; PG8_WAIT_L(0); PG8_MMA(0, 0, At, B0); PG8_BAR; PG8_SCHED;
            PG8_LDB(B1, 1, 1); PG8_STAGE(PG8_SB(1, 0), b3, voffB);
            PG8_BAR; PG8_WAIT_L(0); PG8_MMA(0, 1, At, B1); PG8_BAR;
            PG8_LDA(At, 1, 1); PG8_STAGE(PG8_SA(1, 0), a3, voffA);
            PG8_BAR; PG8_WAIT_L(0); PG8_MMA(1, 0, At, B0); PG8_BAR; PG8_SCHED;
            PG8_STAGE(PG8_SB(1, 1), b3 + hstep, voffB);
            PG8_WAIT_V(6); PG8_BAR; PG8_MMA(1, 1, At, B1); PG8_BAR;
            }
        }
        if constexpr (ALIGN_EPI) { if (wr == 0) PG8_BAR; }
        if constexpr (!Epi::AFTER_DRAIN) { E(acc, cur, wr, wc, fr, fq); S.done(cur); }
        if (!has_next) break;
#pragma unroll
        for (int a = 0; a < 2; ++a)
#pragma unroll
            for (int b = 0; b < 2; ++b)
#pragma unroll
                for (int m = 0; m < 4; ++m)
#pragma unroll
                    for (int n = 0; n < 2; ++n) acc[a][b][m][n] = (f32x4){0.f, 0.f, 0.f, 0.f};
        cur = nxt; cA = nA; cB = nB; ++ui;
        if constexpr (ALIGN_EPI) { if (wr == 1) PG8_BAR; }
    }
    PG8_WAIT_V(0);
    if constexpr (!ALIGN_EPI) { if (wr == 0) PG8_BAR; }
    PG8_BAR;
    if constexpr (Epi::AFTER_DRAIN) { E.fused(acc, cur, wr, wc, fr, fq, lds, wid, lane); S.done(cur); }
#undef PG8_SA
#undef PG8_SB
#undef PG8_STAGE
#undef PG8_LDA
#undef PG8_LDB
#undef PG8_MMA
#undef PG8_WAIT_V
#undef PG8_WAIT_L
#undef PG8_BAR
#undef PG8_SCHED
}
}
constexpr int NWAVES = 8, NTHR = 512;
constexpr int BATCH = 16, SEQ = 2048, M = BATCH * SEQ, D = 1024, FF = 2816, NGU = 2 * FF, NIN = 6656;
constexpr int RH = 4, RDK = 128, RDV = 256, RC = 128, RNC = SEQ / RC;
constexpr int MH = 8, MDH = 64, MBLK = 256, MNB = SEQ / MBLK;
constexpr float ALPHA = 1.189207115002721f;
constexpr float LN_EPS = 1e-5f, GN_EPS = 1e-5f;
constexpr size_t MiB = 1u << 20;
constexpr size_t WS_CTL = 0, CTL_ZERO_BYTES = 1 * MiB;
constexpr size_t WS_KM2 = 1 * MiB;
constexpr size_t WS_MCOS = 1 * MiB + 512 * 1024, WS_MSIN = WS_MCOS + 64 * 1024;
constexpr size_t WS_SEL = 1 * MiB + 768 * 1024;
constexpr size_t WS_RCOS = 2 * MiB, WS_RSIN = WS_RCOS + 512 * 1024;
constexpr size_t WS_WIN = 3 * MiB, WS_WRP = 16 * MiB, WS_WMP = 18 * MiB, WS_WOUT = 19 * MiB;
constexpr size_t WS_XNB = 21 * MiB;
constexpr size_t WS_ST = WS_XNB;
constexpr size_t WS_U = 85 * MiB;
constexpr size_t WS_H = WS_U;
constexpr size_t WS_WGU1 = WS_U + 176 * MiB, WS_WD1 = WS_WGU1 + 11 * MiB;
constexpr size_t WS_RQ = WS_U, WS_RK = WS_U + 32 * MiB, WS_MK = WS_U + 64 * MiB, WS_MV = WS_U + 96 * MiB, WS_RV = WS_U + 128 * MiB,
                 WS_SG = WS_U + 192 * MiB, WS_MQ = WS_U + 256 * MiB, WS_GT = WS_U + 288 * MiB;
constexpr size_t WS_T = WS_U, WS_Z = WS_U + 128 * MiB;
constexpr size_t WS_WGU2 = WS_U + 288 * MiB, WS_WD2 = WS_WGU2 + 11 * MiB;
constexpr size_t WS_END = 501 * MiB;
constexpr int RING_BYTES = 131072, LDSCTL_OFF = 143360, LDS_BYTES = 147456;

#ifndef PG8_SP2
#define PG8_SP2 true
#endif
#ifndef PG8_ALIGN
#define PG8_ALIGN true
#endif
namespace pg8 {
typedef unsigned u32x2 __attribute__((ext_vector_type(2)));
__device__ __forceinline__ float bf2f(unsigned short h) { return __uint_as_float((unsigned)h << 16); }
__device__ __forceinline__ float bflo(unsigned w) { return __uint_as_float(w << 16); }
__device__ __forceinline__ float bfhi(unsigned w) { return __uint_as_float(w & 0xffff0000u); }
__device__ __forceinline__ float silu_f(float g) { return g * __builtin_amdgcn_rcpf(1.0f + __builtin_amdgcn_exp2f(-1.4426950408889634f * g)); }
__device__ __forceinline__ float sigm_f(float g) { return __builtin_amdgcn_rcpf(1.0f + __builtin_amdgcn_exp2f(-1.4426950408889634f * g)); }

struct EpiSwiGLU {
    static constexpr bool PERM = true, AFTER_DRAIN = false;
    bf16_t* O; int ldc;
    __device__ __forceinline__ void operator()(const f32x4 (&acc)[2][2][4][2], const Unit& u, int wr, int wc, int fr, int fq) const {
        const int row0 = u.pm * BM + wr * 64 + fr, col0 = u.pn * HALF + wc * 32 + 8 * fq;
#pragma unroll
        for (int ai = 0; ai < 2; ++ai)
#pragma unroll
            for (int m = 0; m < 4; ++m) { bf16_t* rowp = O + (size_t)(row0 + ai * HALF + m * 16) * ldc + col0;
                float h[8];
#pragma unroll
                for (int n = 0; n < 2; ++n)
#pragma unroll
                    for (int i = 0; i < 4; ++i) h[n * 4 + i] = silu_f(acc[ai][0][m][n][i]) * acc[ai][1][m][n][i];
                u32x4 w; w.x = cvt_pk_bf16(h[0], h[1]); w.y = cvt_pk_bf16(h[2], h[3]); w.z = cvt_pk_bf16(h[4], h[5]); w.w = cvt_pk_bf16(h[6], h[7]);
                *(u32x4*)rowp = w; }
    }
};
struct EpiResid {
    static constexpr bool PERM = false, AFTER_DRAIN = false;
    const float* base; float* out; int ldc; float alpha, s;
    __device__ __forceinline__ void operator()(const f32x4 (&acc)[2][2][4][2], const Unit& u, int wr, int wc, int fr, int fq) const {
        const int row0 = u.pm * BM + wr * 64 + fr, col0 = u.pn * BM + wc * 32 + 4 * fq;
#pragma unroll
        for (int ai = 0; ai < 2; ++ai)
#pragma unroll
            for (int m = 0; m < 4; ++m) { const size_t off = (size_t)(row0 + ai * HALF + m * 16) * ldc + col0;
#pragma unroll
                for (int bj = 0; bj < 2; ++bj)
#pragma unroll
                    for (int n = 0; n < 2; ++n) { const f32x4 b = *(const f32x4*)(base + off + bj * HALF + n * 16);
                        *(f32x4*)(out + off + bj * HALF + n * 16) = b * alpha + acc[ai][bj][m][n] * s; } }
    }
};
__device__ __forceinline__ u32x4 pack8(const f32x4 a, const f32x4 b) { u32x4 w; w.x = cvt_pk_bf16(a[0], a[1]); w.y = cvt_pk_bf16(a[2], a[3]); w.z = cvt_pk_bf16(b[0], b[1]); w.w = cvt_pk_bf16(b[2], b[3]); return w; }
struct EpiProj {
    static constexpr bool PERM = true, AFTER_DRAIN = false;
    unsigned char* ws;
    template <int ACT> __device__ __forceinline__ void plain(const f32x4 (&acc)[2][2][4][2], bf16_t* dst, int ldc, int row0, int col0) const {
#pragma unroll
        for (int ai = 0; ai < 2; ++ai)
#pragma unroll
            for (int m = 0; m < 4; ++m) { bf16_t* rowp = dst + (size_t)(row0 + ai * HALF + m * 16) * ldc + col0;
#pragma unroll
                for (int bj = 0; bj < 2; ++bj) { f32x4 v0 = acc[ai][bj][m][0], v1 = acc[ai][bj][m][1];
                    if (ACT == 1) {
#pragma unroll
                        for (int i = 0; i < 4; ++i) { v0[i] = silu_f(v0[i]); v1[i] = silu_f(v1[i]); } }
                    if (ACT == 2) {
#pragma unroll
                        for (int i = 0; i < 4; ++i) { v0[i] = sigm_f(v0[i]); v1[i] = sigm_f(v1[i]); } }
                    *(u32x4*)(rowp + bj * HALF) = pack8(v0, v1); } }
    }
    template <bool ROT> __device__ __forceinline__ void moba_qk(const f32x4 (&acc)[2][2][4][2], bf16_t* dst, int row0, int c0, int c1, float sc) const {
        const float* mcos = (const float*)(ws + WS_MCOS); const float* msin = (const float*)(ws + WS_MSIN);
#pragma unroll
        for (int ai = 0; ai < 2; ++ai)
#pragma unroll
            for (int m = 0; m < 4; ++m) { const int r = row0 + ai * HALF + m * 16, pos = r & 2047;
                f32x4 o0 = acc[ai][0][m][0], o1 = acc[ai][0][m][1], p0 = acc[ai][1][m][0], p1 = acc[ai][1][m][1];
                if (ROT) { const f32x4 cc0 = *(const f32x4*)(mcos + pos * 8), cc1 = *(const f32x4*)(mcos + pos * 8 + 4), s0 = *(const f32x4*)(msin + pos * 8), s1 = *(const f32x4*)(msin + pos * 8 + 4);
                    const f32x4 a0 = o0, a1 = o1, b0 = p0, b1 = p1;
                    o0 = a0 * cc0 - b0 * s0; o1 = a1 * cc1 - b1 * s1; p0 = a0 * s0 + b0 * cc0; p1 = a1 * s1 + b1 * cc1; }
                o0 = o0 * sc; o1 = o1 * sc; p0 = p0 * sc; p1 = p1 * sc;
                bf16_t* rowp = dst + (size_t)r * 512;
                *(u32x4*)(rowp + c0) = pack8(o0, o1); *(u32x4*)(rowp + c1) = pack8(p0, p1);
                asm volatile("" ::: "memory"); }
    }
    __device__ __forceinline__ void operator()(const f32x4 (&acc)[2][2][4][2], const Unit& u, int wr, int wc, int fr, int fq) const {
        asm volatile("" : "+v"(fr), "+v"(fq));
        const int pn = u.pn; const int row0 = u.pm * BM + wr * 64 + fr;
        if (pn < 4) {
            const bool isk = pn >= 2; bf16_t* dst = (bf16_t*)(ws + (isk ? WS_RK : WS_RQ)); const float* rcos = (const float*)(ws + WS_RCOS); const float* rsin = (const float*)(ws + WS_RSIN);
            const int head = 2 * (pn & 1) + (wc >> 1), dd0 = 32 * (wc & 1) + 8 * fq;
            const float lg2 = __builtin_log2f(1.0f - __builtin_amdgcn_exp2f(-5.0f - (float)head)); const float fs = isk ? -lg2 : lg2, fm = isk ? 0.08838834764831845f : 1.0f;
#pragma unroll
            for (int ai = 0; ai < 2; ++ai)
#pragma unroll
                for (int m = 0; m < 4; ++m) { const int r = row0 + ai * HALF + m * 16, pos = r & 2047, cp = pos & 127;
                    const float f = fm * __builtin_amdgcn_exp2f(fs * (float)cp);
                    const f32x4 c0 = *(const f32x4*)(rcos + pos * 64 + dd0), c1 = *(const f32x4*)(rcos + pos * 64 + dd0 + 4), s0 = *(const f32x4*)(rsin + pos * 64 + dd0), s1 = *(const f32x4*)(rsin + pos * 64 + dd0 + 4);
                    const f32x4 a0 = acc[ai][0][m][0], a1 = acc[ai][0][m][1], b0 = acc[ai][1][m][0], b1 = acc[ai][1][m][1];
                    const f32x4 o0 = (a0 * c0 - b0 * s0) * f, o1 = (a1 * c1 - b1 * s1) * f, p0 = (a0 * s0 + b0 * c0) * f, p1 = (a1 * s1 + b1 * c1) * f;
                    bf16_t* rowp = dst + (size_t)r * 512 + head * 128 + dd0;
                    *(u32x4*)rowp = pack8(o0, o1); *(u32x4*)(rowp + 64) = pack8(p0, p1);
                    asm volatile("" ::: "memory"); }
        }
        else if (pn >= 12 && pn < 16) {
            const bool isk = pn >= 14; bf16_t* dst = (bf16_t*)(ws + (isk ? WS_MK : WS_MQ)); const int tile = pn & 1; const float sc = isk ? 1.0f : 0.125f * 1.4426950408889634f;
            int c0, c1;
            if (wc == 0) { c0 = (4 * tile + fq) * 64; c1 = c0 + 8; moba_qk<true>(acc, dst, row0, c0, c1, sc); }
            else { const int i0 = 32 * wc + 8 * fq - 32, i1 = i0 + 96; const int h0 = i0 / 48, h1 = i1 / 48;
                c0 = (4 * tile + h0) * 64 + 16 + (i0 - 48 * h0); c1 = (4 * tile + h1) * 64 + 16 + (i1 - 48 * h1); moba_qk<false>(acc, dst, row0, c0, c1, sc); }
        }
        else {
            const int cw = wc * 32 + 8 * fq;
            if (pn < 8) plain<0>(acc, (bf16_t*)(ws + WS_RV), 1024, row0, (pn - 4) * BM + cw);
            else if (pn < 12) plain<1>(acc, (bf16_t*)(ws + WS_SG), 1024, row0, (pn - 8) * BM + cw);
            else if (pn < 18) plain<0>(acc, (bf16_t*)(ws + WS_MV), 512, row0, (pn - 16) * BM + cw);
            else plain<2>(acc, (bf16_t*)(ws + WS_GT), 2048, row0, (pn - 18) * BM + cw);
        }
    }
};
struct EpiGateA {
    static constexpr bool PERM = false, AFTER_DRAIN = false;
    const bf16_t* gt; float* T;
    __device__ __forceinline__ void operator()(const f32x4 (&acc)[2][2][4][2], const Unit& u, int wr, int wc, int fr, int fq) const {
        const int row0 = u.pm * BM + wr * 64 + fr, col0 = u.pn * BM + wc * 32 + 4 * fq;
#pragma unroll
        for (int ai = 0; ai < 2; ++ai)
#pragma unroll
            for (int m = 0; m < 4; ++m) { const size_t r = (size_t)(row0 + ai * HALF + m * 16);
#pragma unroll
                for (int bj = 0; bj < 2; ++bj)
#pragma unroll
                    for (int n = 0; n < 2; ++n) { const int c = col0 + bj * HALF + n * 16; const u32x2 g = *(const u32x2*)(gt + r * 2048 + c);
                        f32x4 o; o[0] = bflo(g.x) * acc[ai][bj][m][n][0]; o[1] = bfhi(g.x) * acc[ai][bj][m][n][1]; o[2] = bflo(g.y) * acc[ai][bj][m][n][2]; o[3] = bfhi(g.y) * acc[ai][bj][m][n][3];
                        *(f32x4*)(T + r * 1024 + c) = o; } }
    }
};
struct EpiGateB {
    static constexpr bool PERM = false, AFTER_DRAIN = false;
    const bf16_t* gt; const float* T; bf16_t* Z;
    __device__ __forceinline__ void operator()(const f32x4 (&acc)[2][2][4][2], const Unit& u, int wr, int wc, int fr, int fq) const {
        const int row0 = u.pm * BM + wr * 64 + fr, col0 = u.pn * BM + wc * 32 + 4 * fq;
#pragma unroll
        for (int ai = 0; ai < 2; ++ai)
#pragma unroll
            for (int m = 0; m < 4; ++m) { const size_t r = (size_t)(row0 + ai * HALF + m * 16);
#pragma unroll
                for (int bj = 0; bj < 2; ++bj)
#pragma unroll
                    for (int n = 0; n < 2; ++n) { const int c = col0 + bj * HALF + n * 16; const u32x2 g = *(const u32x2*)(gt + r * 2048 + 1024 + c);
                        const f32x4 t = *(const f32x4*)(T + r * 1024 + c);
                        const float o0 = t[0] + bflo(g.x) * acc[ai][bj][m][n][0], o1 = t[1] + bfhi(g.x) * acc[ai][bj][m][n][1], o2 = t[2] + bflo(g.y) * acc[ai][bj][m][n][2], o3 = t[3] + bfhi(g.y) * acc[ai][bj][m][n][3];
                        u32x2 w; w.x = cvt_pk_bf16(o0, o1); w.y = cvt_pk_bf16(o2, o3);
                        *(u32x2*)(Z + r * 1024 + c) = w; } }
    }
};
}
#include <hip/hip_bf16.h>
#include <cmath>
namespace moba_body {
using bf16=__hip_bfloat16;
using bf16x8=__attribute__((ext_vector_type(8)))short;
using s16x4=__attribute__((ext_vector_type(4)))short;
using f32x16=__attribute__((ext_vector_type(16)))float;
using u32x4=__attribute__((ext_vector_type(4)))unsigned;
constexpr int BATCH=16,NHEAD=8,SEQ=2048,D=64,DM=NHEAD*D;
constexpr int NW=8,QBLK=32,QB=QBLK*NW,KVBLK=64,NQB=SEQ/QB;
constexpr int ATTN_PITCH=DM, ATTN_UNIT_ROWS=QB;
__device__ __forceinline__ int crow(int r,int hi){return (r&3)+8*(r>>2)+4*hi;}
#define SBAR() __builtin_amdgcn_sched_barrier(0)
__device__ __forceinline__ void cmask(f32x16&p0,f32x16&p1,int jb,int qrel,int hi){
  const float NEG=-INFINITY; int kb=64*jb+4*hi;
  #pragma unroll
  for(int r=0;r<16;++r){int kv=kb+(r&3)+8*(r>>2); if(kv>qrel)p0[r]=NEG; if(kv+32>qrel)p1[r]=NEG;}
}

constexpr int NSLOT=3, SLOTB=8192;
constexpr int LDS_K=0, LDS_V=NSLOT*SLOTB, LDS_WS=2*NSLOT*SLOTB, LDS_OST=LDS_WS+NW*64*4, LDS_BYTES=LDS_OST+NW*4096;
constexpr float C2=0.125f*1.4426950408889634f;
__device__ __forceinline__ void glds16(const void*sbase,unsigned voff,unsigned lds_dst){unsigned keep;
  asm volatile("s_mov_b32 %0, m0\n\ts_mov_b32 m0, %3\n\ts_nop 0\n\tglobal_load_lds_dwordx4 %1, %2\n\ts_mov_b32 m0, %0":"=&s"(keep):"v"(voff),"s"(sbase),"s"(lds_dst):"memory");}
__device__ __forceinline__ float max3f(float a,float b,float c){float r;asm("v_max3_f32 %0, %1, %2, %3":"=v"(r):"v"(a),"v"(b),"v"(c));return r;}
__device__ __forceinline__ float max2f(float a,float b){float r;asm("v_max_f32_e32 %0, %1, %2":"=v"(r):"v"(a),"v"(b));return r;}
__device__ __forceinline__ float fadd_s(float a,float b){float r;asm("v_add_f32_e32 %0, %1, %2":"=v"(r):"v"(a),"v"(b));return r;}
__device__ __forceinline__ float fsub_s(float a,float b){float r;asm("v_sub_f32_e32 %0, %1, %2":"=v"(r):"v"(a),"v"(b));return r;}
typedef float f32x2_t __attribute__((ext_vector_type(2))); typedef __bf16 bf16x2_t __attribute__((ext_vector_type(2)));
__device__ __forceinline__ unsigned cvtpk_s(float lo,float hi){f32x2_t v={lo,hi};bf16x2_t b=__builtin_convertvector(v,bf16x2_t);return __builtin_bit_cast(unsigned,b);}
#define WAIT_BAR(N) asm volatile("s_waitcnt vmcnt(" #N ") lgkmcnt(0)\n\ts_barrier":::"memory")

__device__ __forceinline__ void qkt(f32x16&p0,f32x16&p1,const char*Kslot,const bf16x8*qr,const f32x16&negm,int r32,int hi){
  const char*kb=Kslot+hi*1024+r32*16;
  #pragma unroll
  for(int d0=0;d0<4;++d0){
    const bf16x8 b0=*reinterpret_cast<const bf16x8*>(kb+d0*2048);
    const bf16x8 b1=*reinterpret_cast<const bf16x8*>(kb+d0*2048+512);
    if(d0==0){p0=__builtin_amdgcn_mfma_f32_32x32x16_bf16(b0,qr[0],negm,0,0,0);p1=__builtin_amdgcn_mfma_f32_32x32x16_bf16(b1,qr[0],negm,0,0,0);}
    else{p0=__builtin_amdgcn_mfma_f32_32x32x16_bf16(b0,qr[d0],p0,0,0,0);p1=__builtin_amdgcn_mfma_f32_32x32x16_bf16(b1,qr[d0],p1,0,0,0);}}
}
typedef __attribute__((address_space(3))) const char* lds_cptr;
typedef short v4i16_t __attribute__((ext_vector_type(4)));
__device__ __forceinline__ void kload8(bf16x8*kf,lds_cptr kp){
  kf[0]=*(const __attribute__((address_space(3))) bf16x8*)(kp);      kf[1]=*(const __attribute__((address_space(3))) bf16x8*)(kp+512);
  kf[2]=*(const __attribute__((address_space(3))) bf16x8*)(kp+2048); kf[3]=*(const __attribute__((address_space(3))) bf16x8*)(kp+2560);
  kf[4]=*(const __attribute__((address_space(3))) bf16x8*)(kp+4096); kf[5]=*(const __attribute__((address_space(3))) bf16x8*)(kp+4608);
  kf[6]=*(const __attribute__((address_space(3))) bf16x8*)(kp+6144); kf[7]=*(const __attribute__((address_space(3))) bf16x8*)(kp+6656);
}
__device__ __forceinline__ void kload2(bf16x8*kf,lds_cptr kp,int j){ kf[2*j]=*(const __attribute__((address_space(3))) bf16x8*)(kp+j*2048); kf[2*j+1]=*(const __attribute__((address_space(3))) bf16x8*)(kp+j*2048+512); }
__device__ __forceinline__ s16x4 vtr(lds_cptr p){ return __builtin_bit_cast(s16x4,__builtin_amdgcn_ds_read_tr16_b64_v4i16((__attribute__((address_space(3))) v4i16_t*)p)); }
__device__ __forceinline__ float rowmax(const f32x16&p0,const f32x16&p1){
  float a=max3f(p0[0],p0[1],p1[0]),b=max3f(p0[2],p0[3],p1[1]);a=max3f(a,p1[2],p1[3]);
  #pragma unroll
  for(int r=4;r<16;r+=4){a=max3f(a,p0[r],p0[r+1]);b=max3f(b,p0[r+2],p0[r+3]);a=max3f(a,p1[r],p1[r+1]);b=max3f(b,p1[r+2],p1[r+3]);}
  const float m=max2f(a,b);
  auto rr=__builtin_amdgcn_permlane32_swap(__float_as_uint(m),__float_as_uint(m),false,false);
  return max2f(__uint_as_float(rr[0]),__uint_as_float(rr[1]));
}
__device__ __forceinline__ void pv(f32x16*o,int vb,bf16x8 pa0,bf16x8 pa1,bf16x8 pa2,bf16x8 pa3){
  #pragma unroll
  for(int d0=0;d0<2;++d0){s16x4 lo[4],hi[4];
    #pragma unroll
    for(int ks=0;ks<4;++ks){
      asm volatile("ds_read_b64_tr_b16 %0,%1 offset:%c2":"=&v"(lo[ks]):"v"(vb),"i"(d0*4096+ks*1024):"memory");
      asm volatile("ds_read_b64_tr_b16 %0,%1 offset:%c2":"=&v"(hi[ks]):"v"(vb),"i"(d0*4096+ks*1024+512):"memory");}
    asm volatile("s_waitcnt lgkmcnt(0)":::"memory");SBAR();
    #define PK(k) (bf16x8){lo[k][0],lo[k][1],lo[k][2],lo[k][3],hi[k][0],hi[k][1],hi[k][2],hi[k][3]}
    o[d0]=__builtin_amdgcn_mfma_f32_32x32x16_bf16(pa0,PK(0),o[d0],0,0,0);
    o[d0]=__builtin_amdgcn_mfma_f32_32x32x16_bf16(pa1,PK(1),o[d0],0,0,0);
    o[d0]=__builtin_amdgcn_mfma_f32_32x32x16_bf16(pa2,PK(2),o[d0],0,0,0);
    o[d0]=__builtin_amdgcn_mfma_f32_32x32x16_bf16(pa3,PK(3),o[d0],0,0,0);
    #undef PK
  }
}

#ifndef ATTN_STORE16
#define ATTN_STORE16(p,v) (*(u32x4*)(p)=(v))
#endif
template<int THRL> __device__ __forceinline__ void attn_unit(int b,int h,int qb,const bf16*Q,const bf16*__restrict__ K,const bf16*__restrict__ V,bf16*O,const unsigned char*__restrict__ SEL,char*shm,int wave_id){
  const int tid=tid_from(wave_id),lane=tid&63,r32=lane&31,hi=lane>>5; const int wid=__builtin_amdgcn_readfirstlane(tid>>6);
  const long rowbase=(long)b*SEQ; const int q0=qb*QB;
  const bf16*Qw=Q+(rowbase+q0+wid*QBLK)*DM+h*D;
  const bf16*Kh=K+rowbase*DM+h*D,*Vh=V+rowbase*DM+h*D;
  const unsigned lds0=(unsigned)(uintptr_t)shm;
  float*wsf=(float*)(shm+LDS_WS)+wid*64;
  const unsigned ksrc=(unsigned)(lane*DM+wid*8)*2u;
  const unsigned vsrc=(unsigned)((16*(wid&3)+(lane>>2))*DM+(wid>>2)*32+(lane&3)*8)*2u;
  const unsigned kdst=lds0+LDS_K+wid*1024, vdst=lds0+LDS_V+wid*1024;
  #define KT(x) ((x)<4?NT-4+(x):(x)-4)
  #define DMA_K(t,slot) glds16(Kh+(long)KT(t)*KVBLK*DM,ksrc,(unsigned)__builtin_amdgcn_readfirstlane(kdst+(slot)))
  #define DMA_V(t,slot) glds16(Vh+(long)KT(t)*KVBLK*DM,vsrc,(unsigned)__builtin_amdgcn_readfirstlane(vdst+(slot)))
  const int vb0=(int)(lds0+LDS_V)+((lane>>4)&1)*32+(lane&3)*8+(4*hi+((lane&15)>>2))*64;
  const char*Kbase=shm+LDS_K; bf16x8 kf[8];
  const lds_cptr shm3=(lds_cptr)shm; const lds_cptr kp0=shm3+LDS_K+hi*1024+r32*16; const lds_cptr vp0=shm3+LDS_V+((lane>>4)&1)*32+(lane&3)*8+(4*hi+((lane&15)>>2))*64;
  const int NT=(q0+QB)/KVBLK;
  DMA_K(0,0);DMA_V(0,0);DMA_K(1,SLOTB);
  bf16x8 qr[4];
  #pragma unroll
  for(int d0=0;d0<4;++d0)qr[d0]=*reinterpret_cast<const bf16x8*>(&Qw[(long)r32*DM+d0*16+hi*8]);
  float mhat=0.f,l_reg=0.f;f32x16 o[2];o[0]=f32x16{};o[1]=f32x16{};const f32x16 negm=f32x16{};
  const int qrel=wid*QBLK+r32;
  const unsigned selm=SEL[((long)(b*NHEAD+h))*SEQ+q0+qrel];
  #define CMASK(P0,P1,t) do{ if((t)<4){cmask(P0,P1,(t),qrel,hi);} else if(!((selm>>(((t)-4)>>2))&1u)){ _Pragma("unroll") for(int r_=0;r_<16;++r_){P0[r_]=-INFINITY;P1[r_]=-INFINITY;} } }while(0)
  bool resc=false;
  #define START(P0,P1) do{ const float rm=rowmax(P0,P1); resc=false; \
    { const float dl=rm; mhat=fadd_s(mhat,dl); \
      _Pragma("unroll") for(int r=0;r<16;++r){P0[r]=fsub_s(P0[r],dl);P1[r]=fsub_s(P1[r],dl);} \
      } \
    _Pragma("unroll") for(int r=0;r<16;++r)P0[r]=__builtin_amdgcn_exp2f(P0[r]); }while(0)
  #define RESC() do{ if(resc){ asm volatile("s_waitcnt lgkmcnt(0)":::"memory"); \
      _Pragma("unroll") for(int d_=0;d_<2;++d_) _Pragma("unroll") for(int r=0;r<16;++r)o[d_][r]*=wsf[crow(r,hi)]; } }while(0)
  f32x16 pA0,pA1,pB0,pB1;
  int sl_prev=0,sl_cur=0,sl_next=SLOTB;
  #define ROT() do{sl_prev=sl_cur;sl_cur=sl_next;sl_next=(sl_next==(NSLOT-1)*SLOTB)?0:sl_next+SLOTB;}while(0)
  DMA_K(2,2*SLOTB);
  WAIT_BAR(3);
  qkt(pA0,pA1,Kbase,qr,negm,r32,hi);asm volatile("s_nop 15\n\ts_nop 7":"+v"(pA0),"+v"(pA1));CMASK(pA0,pA1,0);
  START(pA0,pA1);
  _Pragma("unroll") for(int r=0;r<16;++r)pA1[r]=__builtin_amdgcn_exp2f(pA1[r]);
  WAIT_BAR(0);
  DMA_K(3,0);DMA_V(1,SLOTB);
  ROT();
  kload8(kf,kp0+sl_cur);
  WAIT_BAR(2);
  s16x4 vlo[8],vhi[8]; u32x4 pw0,pw1,pw2,pw3;
  #define PKW(P,B) cvtpk_s(P[B],P[B+1])
  #define PAF(k) __builtin_bit_cast(bf16x8,pw##k)
  #define VFR(i) (bf16x8){vlo[i][0],vlo[i][1],vlo[i][2],vlo[i][3],vhi[i][0],vhi[i][1],vhi[i][2],vhi[i][3]}
  #define PIN(x) asm volatile("":"+v"(x))
  #define MX3(a,b,c) __builtin_fmaxf(__builtin_fmaxf((a),(b)),(c))
  #define GAPA(MF,A0,A1,A2,A3,W0,W1,PW) do{ MF; sacc+=A0; sacc+=A1; sacc+=A2; sacc+=A3; PIN(sacc); W0; W1; PIN(PW); SBAR(); }while(0)
  #define EX(v) __builtin_amdgcn_exp2f(v)
  #define GAPB(MF,X,B) do{ MF; X[B]=EX(X[B]); X[B+1]=EX(X[B+1]); X[B+2]=EX(X[B+2]); X[B+3]=EX(X[B+3]); PIN(X); SBAR(); }while(0)
  #define VRD(i) do{ vlo[i]=vtr(vp_+(((i)>>2)*4096+((i)&3)*1024)); vhi[i]=vtr(vp_+(((i)>>2)*4096+((i)&3)*1024+512)); }while(0)
  #define KRD(G,j) do{ if(G){ kload2(kf,kp0+sl_next,j); SBAR(); } }while(0)
  #define STEP(C0,C1,P0,P1,t,GK,GV,GL) do{ SBAR(); \
    const lds_cptr vp_=vp0+sl_prev; \
    VRD(0); SBAR(); float sacc=(P0[0]+P0[1]); \
    GAPA(C0=__builtin_amdgcn_mfma_f32_32x32x16_bf16(kf[0],qr[0],negm,0,0,0), P0[2],P0[3],P0[4],P0[5],     pw0[0]=PKW(P0,0), pw0[1]=PKW(P0,2), pw0); \
    VRD(4); SBAR(); GAPA(C1=__builtin_amdgcn_mfma_f32_32x32x16_bf16(kf[1],qr[0],negm,0,0,0), P0[6],P0[7],P0[8],P0[9],     pw0[2]=PKW(P0,4), pw0[3]=PKW(P0,6), pw0); \
    VRD(1); SBAR(); GAPA(C0=__builtin_amdgcn_mfma_f32_32x32x16_bf16(kf[2],qr[1],C0,0,0,0),   P0[10],P0[11],P0[12],P0[13], pw1[0]=PKW(P0,8), pw1[1]=PKW(P0,10), pw1); \
    VRD(5); SBAR(); GAPA(C1=__builtin_amdgcn_mfma_f32_32x32x16_bf16(kf[3],qr[1],C1,0,0,0),   P0[14],P0[15],P1[0],P1[1],   pw1[2]=PKW(P0,12),pw1[3]=PKW(P0,14), pw1); \
    VRD(2); SBAR(); GAPA(C0=__builtin_amdgcn_mfma_f32_32x32x16_bf16(kf[4],qr[2],C0,0,0,0),   P1[2],P1[3],P1[4],P1[5],     pw2[0]=PKW(P1,0), pw2[1]=PKW(P1,2), pw2); \
    VRD(6); SBAR(); GAPA(C1=__builtin_amdgcn_mfma_f32_32x32x16_bf16(kf[5],qr[2],C1,0,0,0),   P1[6],P1[7],P1[8],P1[9],     pw2[2]=PKW(P1,4), pw2[3]=PKW(P1,6), pw2); \
    VRD(3); SBAR(); GAPA(C0=__builtin_amdgcn_mfma_f32_32x32x16_bf16(kf[6],qr[3],C0,0,0,0),   P1[10],P1[11],P1[12],P1[13], pw3[0]=PKW(P1,8), pw3[1]=PKW(P1,10), pw3); \
    VRD(7); SBAR(); GAPA(C1=__builtin_amdgcn_mfma_f32_32x32x16_bf16(kf[7],qr[3],C1,0,0,0),   P1[14],P1[15],0.f,0.f,       pw3[2]=PKW(P1,12),pw3[3]=PKW(P1,14), pw3); \
    l_reg+=sacc; \
    if(GK){DMA_K((t)+3,sl_cur);} if(GV){DMA_V((t)+1,sl_next);} \
    _Pragma("unroll") for(int r=0;r<16;++r){C0[r]-=mhat;C1[r]-=mhat;} \
    CMASK(C0,C1,t); \
    { float a=MX3(C0[0],C0[1],C1[0]),b=MX3(C0[2],C0[3],C1[1]); a=MX3(a,C1[2],C1[3]); \
      _Pragma("unroll") for(int r=4;r<16;r+=4){a=MX3(a,C0[r],C0[r+1]);b=MX3(b,C0[r+2],C0[r+3]);a=MX3(a,C1[r],C1[r+1]);b=MX3(b,C1[r+2],C1[r+3]);} \
      float rm=__builtin_fmaxf(a,b); { auto rr=__builtin_amdgcn_permlane32_swap(__float_as_uint(rm),__float_as_uint(rm),false,false); rm=__builtin_fmaxf(__uint_as_float(rr[0]),__uint_as_float(rr[1])); } \
      resc=false; \
      if(__builtin_expect(__any(rm>(float)THRL),0)){ const float dl=__builtin_fmaxf(rm,0.f); mhat+=dl; \
        _Pragma("unroll") for(int r=0;r<16;++r){C0[r]-=dl;C1[r]-=dl;} \
        const float f=__builtin_amdgcn_exp2f(-dl); l_reg*=f; if(hi==0)wsf[r32]=f; resc=true; } } \
    SBAR(); \
    GAPB(o[0]=__builtin_amdgcn_mfma_f32_32x32x16_bf16(PAF(0),VFR(0),o[0],0,0,0), C0,0); \
    GAPB(o[1]=__builtin_amdgcn_mfma_f32_32x32x16_bf16(PAF(0),VFR(4),o[1],0,0,0), C0,4); \
    KRD(GL,0); GAPB(o[0]=__builtin_amdgcn_mfma_f32_32x32x16_bf16(PAF(1),VFR(1),o[0],0,0,0), C0,8); \
    KRD(GL,1); GAPB(o[1]=__builtin_amdgcn_mfma_f32_32x32x16_bf16(PAF(1),VFR(5),o[1],0,0,0), C0,12); \
    KRD(GL,2); GAPB(o[0]=__builtin_amdgcn_mfma_f32_32x32x16_bf16(PAF(2),VFR(2),o[0],0,0,0), C1,0); \
    KRD(GL,3); GAPB(o[1]=__builtin_amdgcn_mfma_f32_32x32x16_bf16(PAF(2),VFR(6),o[1],0,0,0), C1,4); \
    GAPB(o[0]=__builtin_amdgcn_mfma_f32_32x32x16_bf16(PAF(3),VFR(3),o[0],0,0,0), C1,8); \
    GAPB(o[1]=__builtin_amdgcn_mfma_f32_32x32x16_bf16(PAF(3),VFR(7),o[1],0,0,0), C1,12); \
    }while(0)
  int t=1;
  for(;t+5<NT;t+=2){
    STEP(pB0,pB1,pA0,pA1,t,true,true,true);     WAIT_BAR(2); RESC(); ROT();
    STEP(pA0,pA1,pB0,pB1,t+1,true,true,true);   WAIT_BAR(2); RESC(); ROT();
  }
  #define ENDW(tt) do{ if((tt)+3<NT){WAIT_BAR(2);} else if((tt)+2<NT){WAIT_BAR(1);} else {WAIT_BAR(0);} }while(0)
  for(;t+1<NT;t+=2){
    STEP(pB0,pB1,pA0,pA1,t,(t+3<NT),(t+1<NT),(t+1<NT));       ENDW(t);   RESC(); ROT();
    STEP(pA0,pA1,pB0,pB1,t+1,(t+4<NT),(t+2<NT),(t+2<NT));     ENDW(t+1); RESC(); ROT();
  }
  STEP(pB0,pB1,pA0,pA1,NT-1,false,false,false); RESC();
  { float sacc=pB0[0]+pB0[1]; _Pragma("unroll") for(int r=2;r<16;++r)sacc+=pB0[r]; _Pragma("unroll") for(int r=0;r<16;++r)sacc+=pB1[r]; l_reg+=sacc;
    pw0=(u32x4){PKW(pB0,0),PKW(pB0,2),PKW(pB0,4),PKW(pB0,6)};pw1=(u32x4){PKW(pB0,8),PKW(pB0,10),PKW(pB0,12),PKW(pB0,14)};pw2=(u32x4){PKW(pB1,0),PKW(pB1,2),PKW(pB1,4),PKW(pB1,6)};pw3=(u32x4){PKW(pB1,8),PKW(pB1,10),PKW(pB1,12),PKW(pB1,14)};
    SBAR(); pv(o,vb0+sl_cur,PAF(0),PAF(1),PAF(2),PAF(3)); }
  #undef PKW
  #undef PAF
  #undef VFR
  #undef PIN
  #undef MX3
  #undef GAPA
  #undef GAPB
  #undef EX
  #undef VRD
  #undef KRD
  #undef STEP
  #undef ENDW
  {auto rr=__builtin_amdgcn_permlane32_swap(__float_as_uint(l_reg),__float_as_uint(l_reg),false,false);l_reg=__uint_as_float(rr[0])+__uint_as_float(rr[1]);}
  if(hi==0)wsf[32+r32]=l_reg;asm volatile("s_waitcnt lgkmcnt(0)":::"memory");
  float rli[16];
  #pragma unroll
  for(int r=0;r<16;++r)rli[r]=__builtin_amdgcn_rcpf(wsf[32+crow(r,hi)]);
  bf16*Ow=O+(rowbase+q0+wid*QBLK)*DM+h*D;
  { bf16*stg=(bf16*)(shm+LDS_OST)+wid*2048;
    #pragma unroll
    for(int r=0;r<16;++r){const int orow=crow(r,hi);
      #pragma unroll
      for(int d0=0;d0<2;++d0)stg[orow*64+d0*32+r32]=__float2bfloat16(o[d0][r]*rli[r]);}
    asm volatile("s_waitcnt lgkmcnt(0)":::"memory");
    #pragma unroll
    for(int i=0;i<4;++i){const int row=i*8+(lane>>3),ch=lane&7; const u32x4 v=*(const u32x4*)(stg+row*64+ch*8); ATTN_STORE16(Ow+(long)row*DM+ch*8,v);} }
  asm volatile("s_waitcnt lgkmcnt(0)\n\ts_barrier":::"memory");
  #undef DMA_K
  #undef DMA_V
  #undef KT
  #undef CMASK
  #undef START
  #undef RESC
  #undef ROT
}
constexpr int ATTN_LDS_BYTES=LDS_BYTES;
struct AttnTensors { const bf16* Q; const bf16* K; const bf16* V; bf16* O; const unsigned char* SEL; };
struct AttnUnit { int bh; int qb; };
struct StaticOrder {
  int vcu,grid;
  __device__ __forceinline__ explicit StaticOrder(int grid_,int block):vcu((grid_%8==0)?(block%8)*(grid_/8)+block/8:block),grid(grid_){}
  __device__ __forceinline__ bool next(int i,AttnUnit&u)const{ const int v=vcu+(i>>2)*grid; if(v>=BATCH*NHEAD*2)return false; const int s=v&1,ii=i&3; u.bh=v>>1; u.qb=(ii==0)?7-s:(ii==1)?s:(ii==2)?4+s:3-s; return true; }
  __device__ __forceinline__ void a_ready(const AttnUnit&)const{}
  __device__ __forceinline__ void done(const AttnUnit&)const{}
};
template<class Sched,int THRL=8> __device__ __forceinline__ void attn_phase(char*lds,const AttnTensors&T,const Sched&S,int wave_id){
  AttnUnit u;
  for(int i=0;S.next(i,u);++i){ S.a_ready(u); attn_unit<THRL>(u.bh/NHEAD,u.bh%NHEAD,u.qb,T.Q,T.K,T.V,T.O,T.SEL,lds,wave_id); S.done(u); }
}
#undef SBAR
#undef WAIT_BAR
}
namespace cg = cooperative_groups;
#ifndef MK_SINGLE
#define MK_SINGLE 1
#endif
#define GAS __attribute__((address_space(1)))
#define LAS __attribute__((address_space(3)))
typedef unsigned short bf16;
typedef unsigned v4u __attribute__((ext_vector_type(4)));
typedef unsigned v2u __attribute__((ext_vector_type(2)));
typedef float f32x4 __attribute__((ext_vector_type(4)));
__device__ __forceinline__ unsigned f2bf(float f) { unsigned u = __builtin_bit_cast(unsigned, f); return (u + 0x7fffu + ((u >> 16) & 1u)) >> 16; }
__device__ __forceinline__ unsigned pk2(float lo, float hi) { return f2bf(lo) | (f2bf(hi) << 16); }
__device__ __forceinline__ float bf2f(unsigned short h) { return __uint_as_float((unsigned)h << 16); }
__device__ __forceinline__ float bflo(unsigned w) { return __uint_as_float(w << 16); }
__device__ __forceinline__ float bfhi(unsigned w) { return __uint_as_float(w & 0xffff0000u); }
#define LDS_WAIT() asm volatile("s_waitcnt lgkmcnt(0)" ::: "memory")

#define RLX_AGENT __ATOMIC_RELAXED, __HIP_MEMORY_SCOPE_AGENT
#define XB_TMO      128
#define XB_XCNT(j)  (256  + 64 * (j))
#define XB_XSUB(j)  (1280 + 64 * (j))
#define XB_XGEN(j)  (2304 + 64 * (j))
#define XB_TOP      3328
#define XB_TOPGEN   3392
#define XCD_BAR_WORDS 3456
#define XB_SPIN_CAP (1u << 18)

__device__ __forceinline__ unsigned xb_ld(unsigned* p)              { return __hip_atomic_load(p, __ATOMIC_RELAXED, __HIP_MEMORY_SCOPE_AGENT); }
__device__ __forceinline__ unsigned xb_add(unsigned* p, unsigned v) { return __hip_atomic_fetch_add(p, v, __ATOMIC_RELAXED, __HIP_MEMORY_SCOPE_AGENT); }
__device__ __forceinline__ unsigned xb_xcc_id() { return (unsigned)__builtin_amdgcn_s_getreg((3 << 11) | 20) & 0xFu; }
#define XB_SPIN(cond, bar) do { unsigned _sp = 0; while (cond) { __builtin_amdgcn_s_sleep(1); \
    if ((++_sp & 255u) == 0u) { if (xb_ld(&(bar)[XB_TMO])) break; if (_sp > XB_SPIN_CAP) { atomicAdd(&(bar)[XB_TMO], 1u); break; } } } } while (0)

struct XcdBarrier {
    unsigned* bar; unsigned x;
    volatile LAS unsigned* st;
};

__device__ __forceinline__ XcdBarrier xcd_barrier_post(unsigned* bar, volatile LAS unsigned* st, int tid) {
    XcdBarrier b; b.bar = bar; b.x = xb_xcc_id(); b.st = st;
    if (tid == 0) (void)xb_add(&bar[XB_XCNT(b.x)], 1u);
    return b;
}
__device__ __forceinline__ void xcd_barrier_complete(unsigned* bar, unsigned x, unsigned& nloc, unsigned& nx) {
    const unsigned G = gridDim.x * gridDim.y * gridDim.z;
    unsigned sum, cnt, mine, sp = 0u;
    for (;;) {
        sum = 0u; cnt = 0u; mine = 0u;
#pragma unroll
        for (unsigned j = 0; j < 16; ++j) { const unsigned c = xb_ld(&bar[XB_XCNT(j)]); sum += c; cnt += (c > 0u) ? 1u : 0u; mine = (j == x) ? c : mine; }
        if (sum == G) break;
        __builtin_amdgcn_s_sleep(1);
        if ((++sp & 255u) == 0u) { if (xb_ld(&bar[XB_TMO])) break; if (sp > XB_SPIN_CAP) { atomicAdd(&bar[XB_TMO], 1u); break; } }
    }
    nloc = mine > 0u ? mine : 1u; nx = cnt > 0u ? cnt : 1u;
}

__device__ __forceinline__ void xcd_barrier(const XcdBarrier& b, int tid) {
    asm volatile("s_waitcnt vmcnt(0)" ::: "memory");
    __syncthreads();
    if (tid == 0) {
        unsigned* bar = b.bar;
        __builtin_amdgcn_s_waitcnt(0);
        unsigned nloc = b.st[0], nx = b.st[1];
        if (nloc == 0u) { xcd_barrier_complete(bar, b.x, nloc, nx); b.st[0] = nloc; b.st[1] = nx; }
        const unsigned old = xb_add(&bar[XB_XSUB(b.x)], 1u);
        const unsigned gen = old / nloc;
        if (old + 1u == (gen + 1u) * nloc) {
            __builtin_amdgcn_fence(__ATOMIC_RELEASE, "agent");
            asm volatile("s_waitcnt vmcnt(0)" ::: "memory");
            const unsigned og = xb_add(&bar[XB_TOP], 1u);
            const unsigned tg = og / nx;
            if (og + 1u == (tg + 1u) * nx) xb_add(&bar[XB_TOPGEN], 1u);
            else XB_SPIN(xb_ld(&bar[XB_TOPGEN]) == tg, bar);
            __builtin_amdgcn_fence(__ATOMIC_ACQUIRE, "agent");
            xb_add(&bar[XB_XGEN(b.x)], 1u);
            asm volatile("s_waitcnt vmcnt(0)" ::: "memory");
        } else {
            XB_SPIN(xb_ld(&bar[XB_XGEN(b.x)]) == gen, bar);
            __builtin_amdgcn_fence(__ATOMIC_ACQUIRE, "agent");
            asm volatile("s_waitcnt vmcnt(0)" ::: "memory");
        }
    }
    __syncthreads();
}

struct Args { const float* in[15]; float* out; unsigned char* ws; int ph_lo, ph_hi; };
struct Frame {
    LAS unsigned char* lds;
    int tid, lane, wave, G, bid;
    const float* x; float* out; unsigned char* ws;
};

__device__ __forceinline__ float wave_sum(float v) {
#pragma unroll
    for (int o = 1; o < 64; o <<= 1) v += __shfl_xor(v, o);
    return v;
}
__host__ __device__ __forceinline__ int win_dest_row(int n) {
    if (n < 1024) { const int t = n >> 9, c = n & 511, head = c >> 7, d = c & 127; return (t * 2 + (head >> 1)) * 256 + 128 * (d >> 6) + 64 * (head & 1) + (d & 63); }
    if (n >= 3072 && n < 4096) { const int t = (n - 3072) >> 9, c = (n - 3072) & 511, head = c >> 6, d = c & 63, tile = head >> 2, hit = head & 3; int L;
        if (d < 16) L = 128 * (d >> 3) + 8 * hit + (d & 7); else { const int idx = hit * 48 + (d - 16); L = 128 * (idx / 96) + 32 + idx % 96; }
        return 3072 + (t * 2 + tile) * 256 + L; }
    return n;
}
template <bool WINMAP>
__device__ __forceinline__ void transpose_item(const float* W, int K, int N, bf16* WT, int k0, int n0, int drow0, LAS float* scr, int lane) {
#pragma unroll 8
    for (int i = 0; i < 32; ++i) { const int kk = 2 * i + (lane >> 5); scr[kk * 33 + (lane & 31)] = W[(size_t)(k0 + kk) * N + n0 + (lane & 31)]; }
    LDS_WAIT(); asm volatile("" ::: "memory");
    const int c = lane & 7;
#pragma unroll
    for (int j = 0; j < 4; ++j) { const int n = (lane >> 3) + 8 * j; const LAS float* s = scr + (8 * c) * 33 + n;
        v4u o; o.x = pk2(s[0 * 33], s[1 * 33]); o.y = pk2(s[2 * 33], s[3 * 33]); o.z = pk2(s[4 * 33], s[5 * 33]); o.w = pk2(s[6 * 33], s[7 * 33]);
        const int dr = WINMAP ? win_dest_row(n0 + n) : drow0 + n;
        *(v4u*)(WT + (size_t)dr * K + k0 + 8 * c) = o; }
    LDS_WAIT(); asm volatile("" ::: "memory");
}
template <bool WINMAP = false>
__device__ __forceinline__ void transpose_plain(Frame& F, const float* W, int K, int N, bf16* WT, int gw0, int NGW) {
    LAS float* scr = (LAS float*)(F.lds + F.wave * 16384);
    const int nblk = N / 32, nitems = (K / 64) * nblk;
    for (int it = gw0; it < nitems; it += NGW) { const int kb = it / nblk, nb = it % nblk; transpose_item<WINMAP>(W, K, N, WT, 64 * kb, 32 * nb, 32 * nb, scr, F.lane); }
}
__device__ __forceinline__ void transpose_gu(Frame& F, const float* W, bf16* WT, int gw0, int NGW) {
    LAS float* scr = (LAS float*)(F.lds + F.wave * 16384);
    const int nblk = NGU / 32, nitems = (D / 64) * nblk;
    for (int it = gw0; it < nitems; it += NGW) { const int kb = it / nblk, nb = it % nblk; const int n0 = 32 * nb; const int up = n0 >= FF ? 1 : 0, j = n0 - up * FF;
        transpose_item<false>(W, D, NGU, WT, 64 * kb, n0, 256 * (j >> 7) + 128 * up + (j & 127), scr, F.lane); }
}
__device__ __forceinline__ void cvt_rows(Frame& F, const float* X, bf16* XB, int gw0, int NGW) {
    for (int m = gw0; m < M; m += NGW) { const f32x4* xr = (const f32x4*)(X + (size_t)m * D) + F.lane; unsigned long long* o8 = (unsigned long long*)(XB + (size_t)m * D) + F.lane;
#pragma unroll
        for (int j = 0; j < 4; ++j) { const f32x4 v = xr[64 * j]; o8[64 * j] = (unsigned long long)pk2(v.x, v.y) | ((unsigned long long)pk2(v.z, v.w) << 32); } }
}
__device__ __forceinline__ void ln_rows(Frame& F, float* X, bf16* XB, const float* g, const float* b, int gw0, int NGW) {
    for (int m = gw0; m < M; m += NGW) {
        f32x4* xr = (f32x4*)(X + (size_t)m * D) + F.lane;
        f32x4 v[4]; float s = 0.f;
#pragma unroll
        for (int j = 0; j < 4; ++j) { v[j] = xr[64 * j]; s += (v[j].x + v[j].y) + (v[j].z + v[j].w); }
        const float mean = wave_sum(s) * (1.f / D); float s2 = 0.f;
#pragma unroll
        for (int j = 0; j < 4; ++j) { v[j] = v[j] - mean; s2 += (v[j].x * v[j].x + v[j].y * v[j].y) + (v[j].z * v[j].z + v[j].w * v[j].w); }
        const float rstd = 1.f / sqrtf(wave_sum(s2) * (1.f / D) + LN_EPS);
#pragma unroll
        for (int j = 0; j < 4; ++j) { const f32x4 gg = ((const f32x4*)g)[F.lane + 64 * j], bb = ((const f32x4*)b)[F.lane + 64 * j];
            const f32x4 o = v[j] * rstd * gg + bb; xr[64 * j] = o;
            if (XB) ((unsigned long long*)(XB + (size_t)m * D))[F.lane + 64 * j] = (unsigned long long)pk2(o.x, o.y) | ((unsigned long long)pk2(o.z, o.w) << 32); }
    }
}

__device__ __forceinline__ float ret_inv(int i) { return 1.0f / powf(10000.0f, (float)i / 63.0f); }
__device__ __forceinline__ float moba_inv(int i) { return 1.0f / powf(500000.0f, (float)i / 8.0f); }
__device__ __forceinline__ void rope_tables(Frame& F) {
    float* rc = (float*)(F.ws + WS_RCOS); float* rs = (float*)(F.ws + WS_RSIN); float* mc = (float*)(F.ws + WS_MCOS); float* ms = (float*)(F.ws + WS_MSIN);
    for (int u = F.bid * NTHR + F.tid; u < SEQ * 72; u += F.G * NTHR) {
        if (u < SEQ * 64) { const int pos = u >> 6, i = u & 63; const float ang = (float)pos * ret_inv(i); rc[u] = cosf(ang); rs[u] = sinf(ang); }
        else { const int v = u - SEQ * 64, pos = v >> 3, i = v & 7; const float ang = (float)pos * moba_inv(i); mc[v] = cosf(ang); ms[v] = sinf(ang); } }
}
__device__ __forceinline__ float ret_log2g(int h) { return log2f(1.0f - exp2f(-5.0f - (float)h)); }

__device__ __forceinline__ void ret_kv_item(Frame& F, int item) {
    const int n = item & 15, h = (item >> 4) & 3, b = item >> 6, tid = F.tid;
    const size_t row0 = (size_t)b * SEQ + n * RC;
    const bf16* RK = (const bf16*)(F.ws + WS_RK); const bf16* RV = (const bf16*)(F.ws + WS_RV); bf16* ST = (bf16*)(F.ws + WS_ST);
    LAS float* Kf = (LAS float*)F.lds; LAS bf16* Vb = (LAS bf16*)(F.lds + 65536);
    const float g127 = exp2f(ret_log2g(h) * 127.0f);
    for (int idx = tid; idx < RC * 128; idx += NTHR) { const int k = idx >> 7, i = idx & 127; Kf[k * RDK + i] = bf2f(RK[(row0 + k) * 512 + h * RDK + i]); }
    for (int idx = tid; idx < RC * 32; idx += NTHR) { const int k = idx >> 5, ch = idx & 31;
        *(LAS v4u*)(Vb + k * RDV + ch * 8) = *(const v4u*)(RV + (row0 + k) * 1024 + h * RDV + ch * 8); }
    __syncthreads();
    const int d = tid & 127, eg = tid >> 7;
    float acc[64];
#pragma unroll
    for (int i = 0; i < 64; ++i) acc[i] = 0.f;
    for (int k = 0; k < RC; ++k) { const float kd = Kf[k * RDK + d];
#pragma unroll
        for (int c8 = 0; c8 < 8; ++c8) { const v4u w = *(const LAS v4u*)(Vb + k * RDV + eg * 64 + c8 * 8);
            acc[c8 * 8 + 0] += kd * bflo(w.x); acc[c8 * 8 + 1] += kd * bfhi(w.x); acc[c8 * 8 + 2] += kd * bflo(w.y); acc[c8 * 8 + 3] += kd * bfhi(w.y);
            acc[c8 * 8 + 4] += kd * bflo(w.z); acc[c8 * 8 + 5] += kd * bfhi(w.z); acc[c8 * 8 + 6] += kd * bflo(w.w); acc[c8 * 8 + 7] += kd * bfhi(w.w); } }
#pragma unroll
    for (int i = 0; i < 64; ++i) ST[((size_t)item * RDV + eg * 64 + i) * RDK + d] = (bf16)f2bf(acc[i] * g127);
    __syncthreads();
}
__device__ __forceinline__ void moba_kmean_item(Frame& F, int item) {
    const bf16* MK = (const bf16*)(F.ws + WS_MK); float* KM = (float*)(F.ws + WS_KM2);
    const int ch = F.tid & 63, tg = F.tid >> 6;
    float s[8];
#pragma unroll
    for (int i = 0; i < 8; ++i) s[i] = 0.f;
    for (int t = tg; t < MBLK; t += 8) { const v4u w = *(const v4u*)(MK + ((size_t)item * MBLK + t) * 512 + ch * 8);
        s[0] += bflo(w.x); s[1] += bfhi(w.x); s[2] += bflo(w.y); s[3] += bfhi(w.y); s[4] += bflo(w.z); s[5] += bfhi(w.z); s[6] += bflo(w.w); s[7] += bfhi(w.w); }
    LAS float* red = (LAS float*)F.lds;
#pragma unroll
    for (int i = 0; i < 8; ++i) red[tg * 512 + ch * 8 + i] = s[i];
    __syncthreads();
    { float v = 0.f;
#pragma unroll
      for (int g = 0; g < 8; ++g) v += red[g * 512 + F.tid];
      KM[(size_t)item * 512 + F.tid] = v; }
    __syncthreads();
}
__device__ __forceinline__ void moba_select(Frame& F) {
    const bf16* MQ = (const bf16*)(F.ws + WS_MQ); const float* KM = (const float*)(F.ws + WS_KM2); unsigned char* SEL = (unsigned char*)(F.ws + WS_SEL);
    for (int u = F.bid * NTHR + F.tid; u < BATCH * MH * SEQ; u += F.G * NTHR) { const int s = u & (SEQ - 1), h = (u >> 11) & 7, b = u >> 14, cur = s >> 8;
        unsigned m = (1u << cur) - 1u;
        if (cur > 3) {
            const bf16* qp = MQ + ((size_t)b * SEQ + s) * 512 + h * MDH;
            float q[64];
#pragma unroll
            for (int c8 = 0; c8 < 8; ++c8) { const v4u w = *(const v4u*)(qp + c8 * 8);
                q[c8 * 8 + 0] = bflo(w.x); q[c8 * 8 + 1] = bfhi(w.x); q[c8 * 8 + 2] = bflo(w.y); q[c8 * 8 + 3] = bfhi(w.y); q[c8 * 8 + 4] = bflo(w.z); q[c8 * 8 + 5] = bfhi(w.z); q[c8 * 8 + 6] = bflo(w.w); q[c8 * 8 + 7] = bfhi(w.w); }
            int s0 = 0, s1 = 0, s2 = 0; float g0 = -INFINITY, g1 = -INFINITY, g2 = -INFINITY;
#pragma unroll 1
            for (int nb = 0; nb < cur; ++nb) { const float* km = KM + (size_t)(b * MNB + nb) * 512 + h * MDH; float g = 0.f;
#pragma unroll
                for (int d4 = 0; d4 < 16; ++d4) { const f32x4 k4 = *(const f32x4*)(km + d4 * 4); g += q[d4 * 4] * k4[0] + q[d4 * 4 + 1] * k4[1] + q[d4 * 4 + 2] * k4[2] + q[d4 * 4 + 3] * k4[3]; }
                if (g > g0) { g2 = g1; s2 = s1; g1 = g0; s1 = s0; g0 = g; s0 = nb; } else if (g > g1) { g2 = g1; s2 = s1; g1 = g; s1 = nb; } else if (g > g2) { g2 = g; s2 = nb; } }
            m = (1u << s0) | (1u << s1) | (1u << s2); }
        SEL[u] = (unsigned char)m; }
}
__device__ __forceinline__ void ret_scan(Frame& F) {
    bf16* ST = (bf16*)(F.ws + WS_ST);
    for (int u = F.bid * NTHR + F.tid; u < BATCH * RH * 4096; u += F.G * NTHR) { const int bh = u >> 12, off = (u & 4095) * 8;
        const float dec = exp2f(ret_log2g(bh & 3) * (float)RC);
        float st[8];
#pragma unroll
        for (int j = 0; j < 8; ++j) st[j] = 0.f;
        for (int n = 0; n < RNC; ++n) { v4u* p = (v4u*)(ST + ((size_t)(bh * RNC + n) * (RDV * RDK) + off)); const v4u w = *p;
            v4u o; o.x = pk2(st[0], st[1]); o.y = pk2(st[2], st[3]); o.z = pk2(st[4], st[5]); o.w = pk2(st[6], st[7]); *p = o;
            st[0] = dec * st[0] + bflo(w.x); st[1] = dec * st[1] + bfhi(w.x); st[2] = dec * st[2] + bflo(w.y); st[3] = dec * st[3] + bfhi(w.y);
            st[4] = dec * st[4] + bflo(w.z); st[5] = dec * st[5] + bfhi(w.z); st[6] = dec * st[6] + bflo(w.w); st[7] = dec * st[7] + bfhi(w.w); } }
}
constexpr int QP = 136;
__device__ __forceinline__ void ret_out_item(Frame& F, int item) {
    const int n = item & 15, h = (item >> 4) & 3, b = item >> 6, tid = F.tid;
    const size_t row0 = (size_t)b * SEQ + n * RC;
    const bf16* RQ = (const bf16*)(F.ws + WS_RQ); const bf16* RK = (const bf16*)(F.ws + WS_RK); const bf16* RV = (const bf16*)(F.ws + WS_RV);
    bf16* SG = (bf16*)(F.ws + WS_SG); const bf16* ST = (const bf16*)(F.ws + WS_ST);
    LAS bf16* Qb = (LAS bf16*)F.lds; LAS bf16* Kb = (LAS bf16*)(F.lds + RC * QP * 2); LAS bf16* Vb = (LAS bf16*)F.lds; LAS float* S = (LAS float*)(F.lds + 2 * RC * QP * 2);
    const float lg2 = ret_log2g(h);
    for (int idx = tid; idx < RC * 16; idx += NTHR) { const int k = idx >> 4, ch = idx & 15;
        *(LAS v4u*)(Qb + k * QP + ch * 8) = *(const v4u*)(RQ + (row0 + k) * 512 + h * RDK + ch * 8);
        *(LAS v4u*)(Kb + k * QP + ch * 8) = *(const v4u*)(RK + (row0 + k) * 512 + h * RDK + ch * 8); }
    __syncthreads();
    const int c = tid >> 2, eg = tid & 3;
#pragma unroll 1
    for (int j = 0; j < 32; ++j) { const int k = eg + 4 * j; float dot = 0.f;
        if (k <= c) {
#pragma unroll
            for (int d8 = 0; d8 < 16; ++d8) { const v4u a = *(const LAS v4u*)(Qb + c * QP + d8 * 8), w = *(const LAS v4u*)(Kb + k * QP + d8 * 8);
                dot += bflo(a.x) * bflo(w.x) + bfhi(a.x) * bfhi(w.x) + bflo(a.y) * bflo(w.y) + bfhi(a.y) * bfhi(w.y) + bflo(a.z) * bflo(w.z) + bfhi(a.z) * bfhi(w.z) + bflo(a.w) * bflo(w.w) + bfhi(a.w) * bfhi(w.w); }
            }
        S[c * 129 + k] = dot; }
    float acc[64];
#pragma unroll
    for (int i = 0; i < 64; ++i) acc[i] = 0.f;
    const bf16* stp = ST + ((size_t)item * RDV + eg * 64) * RDK;
#pragma unroll 1
    for (int d8 = 0; d8 < 16; ++d8) { const v4u a = *(const LAS v4u*)(Qb + c * QP + d8 * 8);
        const float q0 = bflo(a.x), q1 = bfhi(a.x), q2 = bflo(a.y), q3 = bfhi(a.y), q4 = bflo(a.z), q5 = bfhi(a.z), q6 = bflo(a.w), q7 = bfhi(a.w);
#pragma unroll
        for (int i8 = 0; i8 < 8; ++i8) {
#pragma unroll
            for (int ii = 0; ii < 8; ++ii) { const int i = i8 * 8 + ii; const v4u w = *(const v4u*)(stp + (size_t)i * RDK + d8 * 8);
                acc[i] += q0 * bflo(w.x) + q1 * bfhi(w.x) + q2 * bflo(w.y) + q3 * bfhi(w.y) + q4 * bflo(w.z) + q5 * bfhi(w.z) + q6 * bflo(w.w) + q7 * bfhi(w.w); }
            asm volatile("" ::: "memory"); } }
    { const float qd = exp2f(lg2);
#pragma unroll
      for (int i = 0; i < 64; ++i) acc[i] *= qd; }
    __syncthreads();
    for (int idx = tid; idx < RC * 32; idx += NTHR) { const int k = idx >> 5, ch = idx & 31;
        *(LAS v4u*)(Vb + k * RDV + ch * 8) = *(const v4u*)(RV + (row0 + k) * 1024 + h * RDV + ch * 8); }
    __syncthreads();
#pragma unroll 1
    for (int k = 0; k <= c; ++k) { const float sv = S[c * 129 + k];
#pragma unroll
        for (int c8 = 0; c8 < 8; ++c8) { const v4u w = *(const LAS v4u*)(Vb + k * RDV + eg * 64 + c8 * 8);
            acc[c8 * 8 + 0] += sv * bflo(w.x); acc[c8 * 8 + 1] += sv * bfhi(w.x); acc[c8 * 8 + 2] += sv * bflo(w.y); acc[c8 * 8 + 3] += sv * bfhi(w.y);
            acc[c8 * 8 + 4] += sv * bflo(w.z); acc[c8 * 8 + 5] += sv * bfhi(w.z); acc[c8 * 8 + 6] += sv * bflo(w.w); acc[c8 * 8 + 7] += sv * bfhi(w.w); } }
    float s = 0.f;
#pragma unroll
    for (int i = 0; i < 64; ++i) s += acc[i];
    s += __shfl_xor(s, 1); s += __shfl_xor(s, 2);
    const float mean = s * (1.f / RDV); float q = 0.f;
#pragma unroll
    for (int i = 0; i < 64; ++i) { acc[i] -= mean; q += acc[i] * acc[i]; }
    q += __shfl_xor(q, 1); q += __shfl_xor(q, 2);
    const float rstd = 1.0f / sqrtf(q * (1.f / RDV) + GN_EPS);
    bf16* yp = SG + (row0 + c) * 1024 + h * RDV + eg * 64;
#pragma unroll
    for (int c8 = 0; c8 < 8; ++c8) { const v4u g = *(const v4u*)(yp + c8 * 8); v4u o;
        o.x = pk2(acc[c8 * 8 + 0] * rstd * bflo(g.x), acc[c8 * 8 + 1] * rstd * bfhi(g.x)); o.y = pk2(acc[c8 * 8 + 2] * rstd * bflo(g.y), acc[c8 * 8 + 3] * rstd * bfhi(g.y));
        o.z = pk2(acc[c8 * 8 + 4] * rstd * bflo(g.z), acc[c8 * 8 + 5] * rstd * bfhi(g.z)); o.w = pk2(acc[c8 * 8 + 6] * rstd * bflo(g.w), acc[c8 * 8 + 7] * rstd * bfhi(g.w));
        *(v4u*)(yp + c8 * 8) = o; }
    __syncthreads();
}
__device__ __forceinline__ void moba_item(Frame& F, int item) {
    const int q512 = item & 3, h = (item >> 2) & 7, b = item >> 5;
    const int s = q512 * 512 + F.tid, cur = s >> 8;
    bf16* MQ = (bf16*)(F.ws + WS_MQ); const bf16* MK = (const bf16*)(F.ws + WS_MK); const bf16* MV = (const bf16*)(F.ws + WS_MV); const float* KM = (const float*)(F.ws + WS_KM2);
    bf16* qp = MQ + ((size_t)b * SEQ + s) * 512 + h * MDH;
    float q[64];
#pragma unroll
    for (int c8 = 0; c8 < 8; ++c8) { const v4u w = *(const v4u*)(qp + c8 * 8);
        q[c8 * 8 + 0] = bflo(w.x); q[c8 * 8 + 1] = bfhi(w.x); q[c8 * 8 + 2] = bflo(w.y); q[c8 * 8 + 3] = bfhi(w.y); q[c8 * 8 + 4] = bflo(w.z); q[c8 * 8 + 5] = bfhi(w.z); q[c8 * 8 + 6] = bflo(w.w); q[c8 * 8 + 7] = bfhi(w.w); }
    int s0 = -1, s1 = -1, s2 = -1; float g0 = -INFINITY, g1 = -INFINITY, g2 = -INFINITY;
#pragma unroll
    for (int nb = 0; nb < 7; ++nb) if (nb < cur) { const float* km = KM + (size_t)(b * MNB + nb) * 512 + h * MDH; float g = 0.f;
#pragma unroll
        for (int d = 0; d < 64; ++d) g += q[d] * km[d];
        if (g > g0) { g2 = g1; s2 = s1; g1 = g0; s1 = s0; g0 = g; s0 = nb; } else if (g > g1) { g2 = g1; s2 = s1; g1 = g; s1 = nb; } else if (g > g2) { g2 = g; s2 = nb; } }
    float mx = -1e30f, l = 0.f, o[64];
#pragma unroll
    for (int d = 0; d < 64; ++d) o[d] = 0.f;
#pragma unroll 1
    for (int j = 0; j < 4; ++j) { const int blk = j == 0 ? s0 : j == 1 ? s1 : j == 2 ? s2 : cur; if (blk < 0) continue;
        const int nk = j == 3 ? (s & 255) + 1 : MBLK;
        const bf16* kb = MK + ((size_t)b * SEQ + blk * MBLK) * 512 + h * MDH; const bf16* vb = MV + ((size_t)b * SEQ + blk * MBLK) * 512 + h * MDH;
#pragma unroll 1
        for (int p = 0; p < nk; ++p) { float sc = 0.f;
#pragma unroll
            for (int c8 = 0; c8 < 8; ++c8) { const v4u w = *(const v4u*)(kb + (size_t)p * 512 + c8 * 8);
                sc += q[c8 * 8 + 0] * bflo(w.x) + q[c8 * 8 + 1] * bfhi(w.x) + q[c8 * 8 + 2] * bflo(w.y) + q[c8 * 8 + 3] * bfhi(w.y) + q[c8 * 8 + 4] * bflo(w.z) + q[c8 * 8 + 5] * bfhi(w.z) + q[c8 * 8 + 6] * bflo(w.w) + q[c8 * 8 + 7] * bfhi(w.w); }
            const float mn = fmaxf(mx, sc), a = exp2f(mx - mn), pw = exp2f(sc - mn); l = l * a + pw; mx = mn;
#pragma unroll
            for (int c8 = 0; c8 < 8; ++c8) { const v4u w = *(const v4u*)(vb + (size_t)p * 512 + c8 * 8);
                o[c8 * 8 + 0] = o[c8 * 8 + 0] * a + pw * bflo(w.x); o[c8 * 8 + 1] = o[c8 * 8 + 1] * a + pw * bfhi(w.x); o[c8 * 8 + 2] = o[c8 * 8 + 2] * a + pw * bflo(w.y); o[c8 * 8 + 3] = o[c8 * 8 + 3] * a + pw * bfhi(w.y);
                o[c8 * 8 + 4] = o[c8 * 8 + 4] * a + pw * bflo(w.z); o[c8 * 8 + 5] = o[c8 * 8 + 5] * a + pw * bfhi(w.z); o[c8 * 8 + 6] = o[c8 * 8 + 6] * a + pw * bflo(w.w); o[c8 * 8 + 7] = o[c8 * 8 + 7] * a + pw * bfhi(w.w); } } }
    const float il = 1.0f / l;
#pragma unroll
    for (int c8 = 0; c8 < 8; ++c8) { v4u w; w.x = pk2(o[c8 * 8 + 0] * il, o[c8 * 8 + 1] * il); w.y = pk2(o[c8 * 8 + 2] * il, o[c8 * 8 + 3] * il); w.z = pk2(o[c8 * 8 + 4] * il, o[c8 * 8 + 5] * il); w.w = pk2(o[c8 * 8 + 6] * il, o[c8 * 8 + 7] * il);
        *(v4u*)(qp + c8 * 8) = w; }
}

typedef short bf16x8 __attribute__((ext_vector_type(8)));
typedef short s16x4 __attribute__((ext_vector_type(4)));
__device__ __forceinline__ s16x4 tr_read(LAS unsigned char* p) { return __builtin_amdgcn_ds_read_tr16_b64_v4i16((LAS s16x4*)p); }
__device__ __forceinline__ bf16x8 tr_pair(LAS unsigned char* p0, LAS unsigned char* p1) { const s16x4 a = tr_read(p0), b = tr_read(p1); return (bf16x8){a[0], a[1], a[2], a[3], b[0], b[1], b[2], b[3]}; }
constexpr int KP = 288, VP = 544, PP = 288;
__device__ __forceinline__ void stage_v(Frame& F, LAS unsigned char* Vimg, size_t row0, int h) {
    const bf16* RV = (const bf16*)(F.ws + WS_RV);
    v4u t[8];
#pragma unroll
    for (int j = 0; j < 8; ++j) { const int idx = F.tid + j * NTHR, k = idx >> 5, ch = idx & 31; t[j] = *(const v4u*)(RV + (row0 + k) * 1024 + h * RDV + ch * 8); }
#pragma unroll
    for (int j = 0; j < 8; ++j) { const int idx = F.tid + j * NTHR, k = idx >> 5, ch = idx & 31; *(LAS v4u*)(Vimg + k * VP + ch * 16) = t[j]; }
}
__device__ __forceinline__ void ret_kv_mfma(Frame& F, int item) {
    const int n = item & 15, h = (item >> 4) & 3, b = item >> 6, tid = F.tid, w = F.wave, lane = F.lane, g = lane >> 4, i = lane & 15;
    const size_t row0 = (size_t)b * SEQ + n * RC;
    const bf16* RK = (const bf16*)(F.ws + WS_RK); bf16* ST = (bf16*)(F.ws + WS_ST);
    LAS unsigned char* Kimg = F.lds; LAS unsigned char* Vimg = F.lds + RC * KP;
    { v4u t[4];
#pragma unroll
      for (int j = 0; j < 4; ++j) { const int idx = tid + j * NTHR, k = idx >> 4, ch = idx & 15; t[j] = *(const v4u*)(RK + (row0 + k) * 512 + h * RDK + ch * 8); }
#pragma unroll
      for (int j = 0; j < 4; ++j) { const int idx = tid + j * NTHR, k = idx >> 4, ch = idx & 15; *(LAS v4u*)(Kimg + k * KP + ch * 16) = t[j]; } }
    stage_v(F, Vimg, row0, h);
    __syncthreads();
    LAS unsigned char* kb = Kimg + (4 * g + (i >> 2)) * KP + (i & 3) * 8;
    LAS unsigned char* vb = Vimg + (4 * g + (i >> 2)) * VP + (i & 3) * 8 + w * 64;
    f32x4 acc[8][2];
#pragma unroll
    for (int dt = 0; dt < 8; ++dt) { acc[dt][0] = (f32x4){0.f, 0.f, 0.f, 0.f}; acc[dt][1] = (f32x4){0.f, 0.f, 0.f, 0.f}; }
#pragma unroll 1
    for (int s = 0; s < 4; ++s) {
        const bf16x8 b0 = tr_pair(vb + s * 32 * VP, vb + s * 32 * VP + 16 * VP), b1 = tr_pair(vb + s * 32 * VP + 32, vb + s * 32 * VP + 16 * VP + 32);
#pragma unroll
        for (int dt = 0; dt < 8; ++dt) { const bf16x8 a = tr_pair(kb + s * 32 * KP + dt * 32, kb + s * 32 * KP + 16 * KP + dt * 32);
            acc[dt][0] = __builtin_amdgcn_mfma_f32_16x16x32_bf16(a, b0, acc[dt][0], 0, 0, 0); acc[dt][1] = __builtin_amdgcn_mfma_f32_16x16x32_bf16(a, b1, acc[dt][1], 0, 0, 0); } }
    const float g127 = exp2f(ret_log2g(h) * 127.0f);
#pragma unroll
    for (int dt = 0; dt < 8; ++dt)
#pragma unroll
        for (int et = 0; et < 2; ++et) { v2u o; o.x = pk2(acc[dt][et][0] * g127, acc[dt][et][1] * g127); o.y = pk2(acc[dt][et][2] * g127, acc[dt][et][3] * g127);
            *(v2u*)(ST + ((size_t)item * RDV + 32 * w + 16 * et + i) * RDK + 16 * dt + 4 * g) = o; }
    __syncthreads();
}
__device__ __forceinline__ void ret_out_mfma(Frame& F, int item) {
    const int n = item & 15, h = (item >> 4) & 3, b = item >> 6, tid = F.tid, w = F.wave, lane = F.lane, g = lane >> 4, i = lane & 15;
    const size_t row0 = (size_t)b * SEQ + n * RC;
    const bf16* RQ = (const bf16*)(F.ws + WS_RQ); const bf16* RK = (const bf16*)(F.ws + WS_RK); bf16* SG = (bf16*)(F.ws + WS_SG); const bf16* ST = (const bf16*)(F.ws + WS_ST);
    LAS unsigned char* Vimg = F.lds; LAS unsigned char* Pimg = F.lds + RC * VP;
    stage_v(F, Vimg, row0, h);
    { v4u t[8];
#pragma unroll
      for (int j = 0; j < 8; ++j) { const int idx = tid + j * NTHR, e = idx >> 4, ch = idx & 15; t[j] = *(const v4u*)(ST + ((size_t)item * RDV + e) * RDK + ch * 8); }
#pragma unroll
      for (int j = 0; j < 8; ++j) { const int idx = tid + j * NTHR, e = idx >> 4, ch = idx & 15; *(LAS v4u*)(Pimg + e * PP + ch * 16) = t[j]; } }
    bf16x8 Qf[4];
#pragma unroll
    for (int ds = 0; ds < 4; ++ds) Qf[ds] = *(const bf16x8*)(RQ + (row0 + 16 * w + i) * 512 + h * RDK + 32 * ds + 8 * g);
    bf16x8 Pb[4];
#pragma unroll
    for (int s = 0; s < 4; ++s) { Pb[s] = (bf16x8){0, 0, 0, 0, 0, 0, 0, 0};
        if (2 * s <= w) {
            f32x4 p0 = (f32x4){0.f, 0.f, 0.f, 0.f}, p1 = (f32x4){0.f, 0.f, 0.f, 0.f};
#pragma unroll
            for (int ds = 0; ds < 4; ++ds) { const bf16x8 kf = *(const bf16x8*)(RK + (row0 + 32 * s + i) * 512 + h * RDK + 32 * ds + 8 * g); p0 = __builtin_amdgcn_mfma_f32_16x16x32_bf16(kf, Qf[ds], p0, 0, 0, 0); }
            if (2 * s + 1 <= w) {
#pragma unroll
                for (int ds = 0; ds < 4; ++ds) { const bf16x8 kf = *(const bf16x8*)(RK + (row0 + 32 * s + 16 + i) * 512 + h * RDK + 32 * ds + 8 * g); p1 = __builtin_amdgcn_mfma_f32_16x16x32_bf16(kf, Qf[ds], p1, 0, 0, 0); } }
            if (2 * s == w) {
#pragma unroll
                for (int r = 0; r < 4; ++r) if (4 * g + r > i) p0[r] = 0.f; }
            if (2 * s + 1 == w) {
#pragma unroll
                for (int r = 0; r < 4; ++r) if (4 * g + r > i) p1[r] = 0.f; }
            v4u pk; pk.x = pk2(p0[0], p0[1]); pk.y = pk2(p0[2], p0[3]); pk.z = pk2(p1[0], p1[1]); pk.w = pk2(p1[2], p1[3]);
            Pb[s] = __builtin_bit_cast(bf16x8, pk); } }
    __syncthreads();
    f32x4 acc[16];
#pragma unroll
    for (int et = 0; et < 16; ++et) acc[et] = (f32x4){0.f, 0.f, 0.f, 0.f};
    LAS unsigned char* pb = Pimg + i * PP + g * 16;
#pragma unroll
    for (int ds = 0; ds < 4; ++ds)
#pragma unroll
        for (int et = 0; et < 16; ++et) { const bf16x8 a = *(const LAS bf16x8*)(pb + et * 16 * PP + ds * 64); acc[et] = __builtin_amdgcn_mfma_f32_16x16x32_bf16(a, Qf[ds], acc[et], 0, 0, 0); }
    { const float gm = exp2f(ret_log2g(h));
#pragma unroll
      for (int et = 0; et < 16; ++et) acc[et] = acc[et] * gm; }
    LAS unsigned char* vb = Vimg + (4 * g + (i >> 2)) * VP + (i & 3) * 8;
#pragma unroll
    for (int s = 0; s < 4; ++s) if (2 * s <= w) {
#pragma unroll
        for (int et = 0; et < 16; ++et) { const bf16x8 a = tr_pair(vb + s * 32 * VP + et * 32, vb + s * 32 * VP + 16 * VP + et * 32); acc[et] = __builtin_amdgcn_mfma_f32_16x16x32_bf16(a, Pb[s], acc[et], 0, 0, 0); } }
    float sm = 0.f;
#pragma unroll
    for (int et = 0; et < 16; ++et) sm += (acc[et][0] + acc[et][1]) + (acc[et][2] + acc[et][3]);
    sm += __shfl_xor(sm, 16); sm += __shfl_xor(sm, 32);
    const float mean = sm * (1.f / RDV); float qv = 0.f;
#pragma unroll
    for (int et = 0; et < 16; ++et) { acc[et] = acc[et] - mean; qv += (acc[et][0] * acc[et][0] + acc[et][1] * acc[et][1]) + (acc[et][2] * acc[et][2] + acc[et][3] * acc[et][3]); }
    qv += __shfl_xor(qv, 16); qv += __shfl_xor(qv, 32);
    const float rstd = 1.0f / sqrtf(qv * (1.f / RDV) + GN_EPS);
    bf16* yp = SG + (row0 + 16 * w + i) * 1024 + h * RDV + 4 * g;
#pragma unroll
    for (int et = 0; et < 16; ++et) { const v2u sg = *(const v2u*)(yp + 16 * et); v2u o;
        o.x = pk2(acc[et][0] * rstd * bflo(sg.x), acc[et][1] * rstd * bfhi(sg.x)); o.y = pk2(acc[et][2] * rstd * bflo(sg.y), acc[et][3] * rstd * bfhi(sg.y));
        *(v2u*)(yp + 16 * et) = o; }
    __syncthreads();
}
constexpr int N_PHASES = 15;
__global__ void __launch_bounds__(NTHR, 2) fwd_kernel(Args args) {
    extern __shared__ __attribute__((aligned(16))) unsigned char lds[];
    Frame F;
    F.lds = (LAS unsigned char*)lds; F.tid = 0; F.lane = 0; F.wave = 0;
    F.G = gridDim.x; F.bid = blockIdx.x; F.x = nullptr; F.out = nullptr; F.ws = nullptr;
    __attribute__((opencl_constant)) const Args* ap = nullptr;
    const int wave0 = __builtin_amdgcn_readfirstlane((int)threadIdx.x >> 6);
    XcdBarrier xbar; xbar.bar = nullptr; xbar.x = 0; xbar.st = nullptr;
#if MK_SINGLE
    { const int t0 = tid_from(wave0); volatile LAS unsigned* MISC = (volatile LAS unsigned*)(F.lds + LDSCTL_OFF);
      for (int u = t0; u < (LDS_BYTES - LDSCTL_OFF) / 4; u += NTHR) MISC[u] = 0u;
      __syncthreads();
      xbar = xcd_barrier_post((unsigned*)(args.ws + WS_CTL) + 4096, MISC + 8, t0); }
#endif
#define WSP (F.ws)
    const int NGW = F.G * NWAVES;
#define gw (F.bid * NWAVES + F.wave)
    const int lo = args.ph_lo, hi = args.ph_hi;
#ifndef PHASE_MASK
#define PHASE_MASK 0x7fff
#endif
#define IN(k) (((PHASE_MASK >> (k)) & 1) && lo <= (k) && (k) < hi)
#if MK_SINGLE
#define SEAM(k) do { if (IN(k) && IN((k) + 1)) { if ((k) == 0) cg::this_grid().sync(); else xcd_barrier(xbar, tid_from(wave0)); } } while (0)
#else
#define SEAM(k) do { } while (0)
#endif
#define PHASE_BEGIN() do { const int t_ = tid_from(wave0); F.tid = t_; F.lane = t_ & 63; F.wave = __builtin_amdgcn_readfirstlane(t_ >> 6); \
        auto kp_ = __builtin_amdgcn_kernarg_segment_ptr(); asm volatile("" : "+s"(kp_)); ap = (decltype(ap))kp_; F.x = ap->in[0]; F.out = ap->out; F.ws = ap->ws; } while (0)
#define XNB ((bf16*)(WSP + WS_XNB))
#define HB ((bf16*)(WSP + WS_H))
    if (IN(0)) { PHASE_BEGIN();
        transpose_gu(F, ap->in[3], (bf16*)(WSP + WS_WGU1), gw, NGW);
        transpose_plain(F, ap->in[4], FF, D, (bf16*)(WSP + WS_WD1), gw, NGW);
        transpose_plain<true>(F, ap->in[5], D, NIN, (bf16*)(WSP + WS_WIN), gw, NGW);
        rope_tables(F);
        transpose_plain(F, ap->in[6], D, D, (bf16*)(WSP + WS_WRP), gw, NGW);
        transpose_plain(F, ap->in[7], 512, D, (bf16*)(WSP + WS_WMP), gw, NGW);
        transpose_plain(F, ap->in[8], D, D, (bf16*)(WSP + WS_WOUT), gw, NGW);
        cvt_rows(F, F.x, XNB, gw, NGW);
        __syncthreads();
    }
    SEAM(0);
    if (IN(1)) { PHASE_BEGIN(); pg8::Gemm g{XNB, (const bf16*)(WSP + WS_WGU1), M, NGU, D}; pg8::StaticOrder S; S.init(M, NGU, F.G, F.bid);
        pg8::EpiSwiGLU E{HB, FF}; pg8::gemm_phase<pg8::EpiSwiGLU, pg8::StaticOrder, PG8_ALIGN, PG8_SP2>(F.lds, g, S, E, wave0); }
    SEAM(1);
    if (IN(2)) { PHASE_BEGIN(); pg8::Gemm g{HB, (const bf16*)(WSP + WS_WD1), M, D, FF}; pg8::StaticOrder S; S.init(M, D, F.G, F.bid);
        pg8::EpiResid E{F.x, F.out, D, ALPHA, 0.5f}; pg8::gemm_phase<pg8::EpiResid, pg8::StaticOrder, PG8_ALIGN, PG8_SP2>(F.lds, g, S, E, wave0); }
    SEAM(2);
    if (IN(3)) { PHASE_BEGIN(); ln_rows(F, F.out, XNB, ap->in[1], ap->in[2], gw, NGW); }
    SEAM(3);
    if (IN(4)) { PHASE_BEGIN(); pg8::Gemm g{XNB, (const bf16*)(WSP + WS_WIN), M, NIN, D}; pg8::StaticOrder S; S.init(M, NIN, F.G, F.bid);
        pg8::EpiProj E{WSP};
        pg8::gemm_phase<pg8::EpiProj, pg8::StaticOrder, PG8_ALIGN, PG8_SP2>(F.lds, g, S, E, wave0); }
    SEAM(4);
    if (IN(5)) { PHASE_BEGIN();
        for (int it = F.bid; it < BATCH * MNB; it += F.G) moba_kmean_item(F, it);
        #ifdef RET_KV_NAIVE
        for (int it = F.bid; it < BATCH * RH * RNC; it += F.G) ret_kv_item(F, it);
#else
        for (int it = F.bid; it < BATCH * RH * RNC; it += F.G) ret_kv_mfma(F, it);
#endif
    }
    SEAM(5);
    if (IN(6)) { PHASE_BEGIN(); ret_scan(F); moba_select(F); }
    SEAM(6);
    if (IN(7)) { PHASE_BEGIN();
        #ifdef RET_OUT_NAIVE
        for (int it = F.bid; it < BATCH * RH * RNC; it += F.G) ret_out_item(F, it);
#else
        for (int it = F.bid; it < BATCH * RH * RNC; it += F.G) ret_out_mfma(F, it);
#endif
#ifdef MOBA_NAIVE
        for (int it = F.bid; it < BATCH * MH * 4; it += F.G) moba_item(F, it);
#else
        __syncthreads();
        { const moba_body::AttnTensors AT{(const moba_body::bf16*)(WSP + WS_MQ), (const moba_body::bf16*)(WSP + WS_MK), (const moba_body::bf16*)(WSP + WS_MV), (moba_body::bf16*)(WSP + WS_MQ), (const unsigned char*)(WSP + WS_SEL)};
          const moba_body::StaticOrder S((int)F.G, (int)blockIdx.x); moba_body::attn_phase<moba_body::StaticOrder>((char*)lds, AT, S, wave0); }
#endif
    }
    SEAM(7);
    if (IN(8)) { PHASE_BEGIN(); pg8::Gemm g{(const bf16*)(WSP + WS_SG), (const bf16*)(WSP + WS_WRP), M, D, D}; pg8::StaticOrder S; S.init(M, D, F.G, F.bid);
        pg8::EpiGateA E{(const bf16*)(WSP + WS_GT), (float*)(WSP + WS_T)}; pg8::gemm_phase<pg8::EpiGateA, pg8::StaticOrder, PG8_ALIGN, PG8_SP2>(F.lds, g, S, E, wave0); }
    SEAM(8);
    if (IN(9)) { PHASE_BEGIN(); pg8::Gemm g{(const bf16*)(WSP + WS_MQ), (const bf16*)(WSP + WS_WMP), M, D, 512}; pg8::StaticOrder S; S.init(M, D, F.G, F.bid);
        pg8::EpiGateB E{(const bf16*)(WSP + WS_GT), (const float*)(WSP + WS_T), (bf16*)(WSP + WS_Z)}; pg8::gemm_phase<pg8::EpiGateB, pg8::StaticOrder, PG8_ALIGN, PG8_SP2>(F.lds, g, S, E, wave0); }
    SEAM(9);
    if (IN(10)) { PHASE_BEGIN();
        transpose_gu(F, ap->in[11], (bf16*)(WSP + WS_WGU2), gw, NGW);
        transpose_plain(F, ap->in[12], FF, D, (bf16*)(WSP + WS_WD2), gw, NGW);
        __syncthreads();
        pg8::Gemm g{(const bf16*)(WSP + WS_Z), (const bf16*)(WSP + WS_WOUT), M, D, D}; pg8::StaticOrder S; S.init(M, D, F.G, F.bid);
        pg8::EpiResid E{F.out, F.out, D, ALPHA, 1.0f}; pg8::gemm_phase<pg8::EpiResid, pg8::StaticOrder, PG8_ALIGN, PG8_SP2>(F.lds, g, S, E, wave0); }
    SEAM(10);
    if (IN(11)) { PHASE_BEGIN(); ln_rows(F, F.out, XNB, ap->in[9], ap->in[10], gw, NGW); }
    SEAM(11);
    if (IN(12)) { PHASE_BEGIN(); pg8::Gemm g{XNB, (const bf16*)(WSP + WS_WGU2), M, NGU, D}; pg8::StaticOrder S; S.init(M, NGU, F.G, F.bid);
        pg8::EpiSwiGLU E{HB, FF}; pg8::gemm_phase<pg8::EpiSwiGLU, pg8::StaticOrder, PG8_ALIGN, PG8_SP2>(F.lds, g, S, E, wave0); }
    SEAM(12);
    if (IN(13)) { PHASE_BEGIN(); pg8::Gemm g{HB, (const bf16*)(WSP + WS_WD2), M, D, FF}; pg8::StaticOrder S; S.init(M, D, F.G, F.bid);
        pg8::EpiResid E{F.out, F.out, D, ALPHA, 0.5f}; pg8::gemm_phase<pg8::EpiResid, pg8::StaticOrder, PG8_ALIGN, PG8_SP2>(F.lds, g, S, E, wave0); }
    SEAM(13);
    if (IN(14)) { PHASE_BEGIN(); ln_rows(F, F.out, nullptr, ap->in[13], ap->in[14], gw, NGW); }
#undef IN
#undef SEAM
#undef PHASE_BEGIN
#undef gw
#undef WSP
#undef XNB
#undef HB
}

extern "C" void kernel_launch(void* const* d_in, const int* in_sizes, int n_in, void* d_out, int out_size, void* d_ws, size_t ws_size, hipStream_t stream) {
    static int grid = 0;
    if (grid == 0) {
        if (n_in != 15 || out_size != M * D || ws_size < WS_END) { fprintf(stderr, "kernel_launch: unexpected shapes (n_in %d out %d ws %zu)\n", n_in, out_size, ws_size); grid = -1; return; }
        int dev = 0, cus = 0, per_cu = 0;
        hipGetDevice(&dev); hipDeviceGetAttribute(&cus, hipDeviceAttributeMultiprocessorCount, dev);
        if (hipFuncSetAttribute((const void*)fwd_kernel, hipFuncAttributeMaxDynamicSharedMemorySize, LDS_BYTES) != hipSuccess) { fprintf(stderr, "hipFuncSetAttribute failed\n"); grid = -1; return; }
        hipOccupancyMaxActiveBlocksPerMultiprocessor(&per_cu, (const void*)fwd_kernel, NTHR, LDS_BYTES);
        (void)hipGetLastError();
        if (per_cu < 1) { fprintf(stderr, "occupancy query says %d blocks per CU\n", per_cu); grid = -1; return; }
        grid = cus;
    }
    if (grid < 0) return;
    (void)hipMemsetAsync((char*)d_ws + WS_CTL, 0, CTL_ZERO_BYTES, stream);
    Args a{};
    for (int i = 0; i < 15; ++i) a.in[i] = (const float*)d_in[i];
    a.out = (float*)d_out; a.ws = (unsigned char*)d_ws;
#if MK_SINGLE
    a.ph_lo = 0; a.ph_hi = N_PHASES;
    void* kargs[] = {&a};
    hipError_t e = hipLaunchCooperativeKernel((const void*)fwd_kernel, dim3(grid), dim3(NTHR), kargs, LDS_BYTES, stream);
    if (e != hipSuccess) fprintf(stderr, "cooperative launch failed: %s (grid %d)\n", hipGetErrorString(e), grid);
#else
    for (int p = 0; p < N_PHASES; ++p) { a.ph_lo = p; a.ph_hi = p + 1; hipLaunchKernelGGL(fwd_kernel, dim3(grid), dim3(NTHR), LDS_BYTES, stream, a); }
#endif
}
```
